# Optimizing an MI355X kernel written in HIP

```python
import jax, jax.numpy as jnp
from jax import lax
import numpy as np

D_MODEL = 1024
BATCH = 2
SEQ = 8192
DEPTH = 2

GRID_W = 64
CTX_LEN = 256
MIX = D_MODEL
D_A = MIX // 2
D_B = MIX // 2
D_C = MIX // 2
D_D = MIX // 2
CONV_A = 31
CONV_B = 4
CONV_C = 3
PAD_A = (CONV_A // 2, CONV_A // 2)
PAD_B = (2, 1)
PAD_C = (1, 1)
LRU_BLOCK = 128
N_LRU_BLOCKS = D_B // LRU_BLOCK
LRU_C = 8.0
HEAD_DIM = 64
N_HEADS_D = D_D // HEAD_DIM
WIN_H = 8
WIN_W = 16
N_EXPERTS = 16
N_GROUPS = 4
EXPERTS_PER_GROUP = N_EXPERTS // N_GROUPS
TOP_K = 2
D_FF = 512
EPS = 1e-6
N_EVEN = (DEPTH + 1) // 2
N_ODD = DEPTH // 2

kernel_name = 'hybrid_conv_lru_shortconv_natten_moe_dit'


def rms_norm(x, g):
    xf = x.astype(jnp.float32)
    y = xf * lax.rsqrt(jnp.mean(xf * xf, -1, keepdims=True) + EPS)
    return (y * g.astype(jnp.float32)).astype(x.dtype)


def layer_norm(x, g, b):
    xf = x.astype(jnp.float32)
    mu = jnp.mean(xf, -1, keepdims=True)
    var = jnp.mean(jnp.square(xf - mu), -1, keepdims=True)
    y = (xf - mu) * lax.rsqrt(var + EPS) * g.astype(jnp.float32) + b.astype(jnp.float32)
    return y.astype(x.dtype)


def depthwise_conv(x, w, pad):
    return lax.conv_general_dilated(x, w[:, None, :].astype(x.dtype), window_strides=(1,), padding=[pad],
                                    dimension_numbers=('NWC', 'WIO', 'NWC'), feature_group_count=x.shape[-1])


def conformer_conv(p, dw_w, dw_b, ln_g, ln_b):
    v, g = jnp.split(p, 2, -1)
    u = v * jax.nn.sigmoid(g)
    u = depthwise_conv(u, dw_w, PAD_A) + dw_b
    return jax.nn.silu(layer_norm(u, ln_g, ln_b))


def rglru_coeffs(v, w_gate, b_gate, lam):
    bsz, length, _ = v.shape
    vb = v.reshape(bsz, length, N_LRU_BLOCKS, LRU_BLOCK)
    gates = jnp.einsum('blnk,gnkj->gblnj', vb, w_gate).reshape(2, bsz, length, D_B) + b_gate[:, None, None, :]
    r = jax.nn.sigmoid(gates[0].astype(jnp.float32))
    i = jax.nn.sigmoid(gates[1].astype(jnp.float32))
    log_a = -LRU_C * r * jax.nn.softplus(-lam.astype(jnp.float32))
    a = jnp.exp(log_a)
    b = jnp.sqrt(-jnp.expm1(2.0 * log_a)) * (i * v.astype(jnp.float32))
    return a, b


def linear_scan(a, b, h0, reverse):
    def combine(left, right):
        a_l, b_l = left
        a_r, b_r = right
        return a_l * a_r, a_r * b_l + b_r
    a_cum, b_cum = lax.associative_scan(combine, (a, b), reverse=reverse, axis=1)
    return a_cum * h0[:, None, :] + b_cum


def rglru_bidir(u_lat, u_ctx, conv_w, conv_b, gate_w, gate_b, lam, with_ctx):
    v_lat = depthwise_conv(u_lat, conv_w, PAD_B) + conv_b
    v_ctx = depthwise_conv(u_ctx, conv_w, PAD_B) + conv_b
    y_lat = jnp.zeros(v_lat.shape, jnp.float32)
    y_ctx = jnp.zeros(v_ctx.shape, jnp.float32)
    for d, rev in enumerate((False, True)):
        a_c, b_c = rglru_coeffs(v_ctx, gate_w[d], gate_b[d], lam[d])
        h_c = linear_scan(a_c, b_c, jnp.zeros_like(b_c[:, 0]), rev)
        h_end = h_c[:, 0] if rev else h_c[:, -1]
        a_l, b_l = rglru_coeffs(v_lat, gate_w[d], gate_b[d], lam[d])
        y_lat = y_lat + linear_scan(a_l, b_l, h_end, rev)
        if with_ctx:
            y_ctx = y_ctx + h_c
    return y_lat.astype(u_lat.dtype), (y_ctx.astype(u_ctx.dtype) if with_ctx else None)


def short_gated_conv(p, conv_w):
    xin, bg, cg = jnp.split(p, 3, -1)
    return bg * depthwise_conv(cg * xin, conv_w, PAD_C)


def context_attention(q, k, v):
    s = jnp.einsum('bqhd,bkhd->bhqk', q, k).astype(jnp.float32) * (HEAD_DIM ** -0.5)
    p = jax.nn.softmax(s, -1).astype(v.dtype)
    o = jnp.einsum('bhqk,bkhd->bqhd', p, v)
    return o.reshape(o.shape[0], o.shape[1], D_D)


def neighbourhood_attention(q, k, v, k_ctx, v_ctx, rpb):
    bsz, seq = q.shape[0], q.shape[1]
    rows = seq // GRID_W
    kh = min(WIN_H, rows)
    kw = WIN_W
    scale = HEAD_DIM ** -0.5
    qg = q.reshape(bsz, rows, GRID_W, N_HEADS_D, HEAD_DIM)
    kg = k.reshape(bsz, rows, GRID_W, N_HEADS_D, HEAD_DIM)
    vg = v.reshape(bsz, rows, GRID_W, N_HEADS_D, HEAD_DIM)
    col = jnp.arange(GRID_W)
    col_start = jnp.clip(col - kw // 2, 0, GRID_W - kw)
    key_cols = col_start[:, None] + jnp.arange(kw)
    col_idx = key_cols - col[:, None] + (WIN_W - 1)
    rpb_f = rpb.astype(jnp.float32)

    def row_block(r):
        r_start = jnp.clip(r - kh // 2, 0, rows - kh)
        q_r = lax.dynamic_index_in_dim(qg, r, axis=1, keepdims=False)
        k_rows = lax.dynamic_slice_in_dim(kg, r_start, kh, axis=1)
        v_rows = lax.dynamic_slice_in_dim(vg, r_start, kh, axis=1)
        k_win = k_rows[:, :, key_cols]
        v_win = v_rows[:, :, key_cols]
        row_idx = r_start + jnp.arange(kh) - r + (WIN_H - 1)
        bias = rpb_f[:, row_idx[None, :, None], col_idx[:, None, :]]
        s_loc = jnp.einsum('bqhd,brqkhd->bhqrk', q_r, k_win).astype(jnp.float32) * scale + bias[None]
        s_ctx = jnp.einsum('bqhd,bchd->bhqc', q_r, k_ctx).astype(jnp.float32) * scale
        s = jnp.concatenate([s_loc.reshape(bsz, N_HEADS_D, GRID_W, kh * kw), s_ctx], -1)
        p = jax.nn.softmax(s, -1).astype(v.dtype)
        p_loc = p[..., :kh * kw].reshape(bsz, N_HEADS_D, GRID_W, kh, kw)
        p_ctx = p[..., kh * kw:]
        return (jnp.einsum('bhqrk,brqkhd->bqhd', p_loc, v_win)
                + jnp.einsum('bhqc,bchd->bqhd', p_ctx, v_ctx))

    out = lax.map(row_block, jnp.arange(rows))
    return out.transpose(1, 0, 2, 3, 4).reshape(bsz, seq, D_D)


def mixer_conv_lru(n_lat, n_ctx, w_in, dw_w, dw_b, ln_g, ln_b, conv_w, conv_b, gate_w, gate_b, lam, with_ctx):
    splits = [2 * D_A, 2 * D_A + D_B]
    a_l, u_l, g_l = jnp.split(n_lat @ w_in, splits, -1)
    a_c, u_c, g_c = jnp.split(n_ctx @ w_in, splits, -1)
    y_l, y_c = rglru_bidir(u_l, u_c, conv_w, conv_b, gate_w, gate_b, lam, with_ctx)
    out_lat = jnp.concatenate([conformer_conv(a_l, dw_w, dw_b, ln_g, ln_b), y_l * jax.nn.gelu(g_l)], -1)
    if not with_ctx:
        return out_lat, None
    out_ctx = jnp.concatenate([conformer_conv(a_c, dw_w, dw_b, ln_g, ln_b), y_c * jax.nn.gelu(g_c)], -1)
    return out_lat, out_ctx


def mixer_conv_natten(n_lat, n_ctx, w_in, conv_w, rpb, with_ctx):
    def heads(t):
        return t.reshape(t.shape[0], t.shape[1], N_HEADS_D, HEAD_DIM)
    p_l = n_lat @ w_in
    p_c = n_ctx @ w_in
    q_l, k_l, v_l = [heads(t) for t in jnp.split(p_l[..., 3 * D_C:], 3, -1)]
    q_c, k_c, v_c = [heads(t) for t in jnp.split(p_c[..., 3 * D_C:], 3, -1)]
    out_lat = jnp.concatenate([short_gated_conv(p_l[..., :3 * D_C], conv_w),
                               neighbourhood_attention(q_l, k_l, v_l, k_c, v_c, rpb)], -1)
    if not with_ctx:
        return out_lat, None
    out_ctx = jnp.concatenate([short_gated_conv(p_c[..., :3 * D_C], conv_w), context_attention(q_c, k_c, v_c)], -1)
    return out_lat, out_ctx


def moe(h, router_w, router_bias, w_gate, w_up, w_down):
    shp = h.shape
    t = h.reshape(-1, D_MODEL)
    score = jax.nn.sigmoid((t @ router_w).astype(jnp.float32))
    sel = (score + router_bias.astype(jnp.float32)).reshape(-1, N_GROUPS, EXPERTS_PER_GROUP)
    group_score = jnp.sum(lax.top_k(sel, TOP_K)[0], -1)
    in_group = jax.nn.one_hot(jnp.argmax(group_score, -1), N_GROUPS, dtype=jnp.bool_)
    masked = jnp.where(in_group[:, :, None], sel, -jnp.inf).reshape(-1, N_EXPERTS)
    _, idx = lax.top_k(masked, TOP_K)
    w = jnp.take_along_axis(score, idx, -1)
    w = w / jnp.sum(w, -1, keepdims=True)
    combine = jnp.sum(jax.nn.one_hot(idx, N_EXPERTS, dtype=jnp.float32) * w[..., None], 1).astype(t.dtype)
    out = jnp.zeros_like(t)
    for e in range(N_EXPERTS):
        hid = jax.nn.silu(t @ w_gate[e]) * (t @ w_up[e])
        out = out + combine[:, e:e + 1] * (hid @ w_down[e])
    return out.reshape(shp)


def setup_inputs(seed: int = 0) -> dict:
    key = jax.random.key(seed)
    ks = jax.random.split(key, 32)
    D = D_MODEL

    def nrm(k, shape, s):
        return jax.random.normal(k, shape, jnp.float32) * s

    a_base = jax.random.uniform(ks[17], (N_EVEN, 2, D_B), jnp.float32, 0.9, 0.999) ** (1.0 / LRU_C)
    b_lambda = jnp.log(a_base) - jnp.log1p(-a_base)
    return {
        'x': nrm(ks[0], (BATCH, SEQ, D), 1.0),
        'c': nrm(ks[1], (BATCH, D), 1.0),
        'ctx': nrm(ks[2], (BATCH, CTX_LEN, D), 1.0),
        'c_ctx': nrm(ks[3], (D,), 1.0),
        'ada_w': nrm(ks[4], (DEPTH, D, 6 * D), 0.5 * D ** -0.5),
        'ada_b': nrm(ks[5], (DEPTH, 6 * D), 0.01),
        'norm_mix_g': 1.0 + nrm(ks[6], (DEPTH, D), 0.05),
        'norm_ffn_g': 1.0 + nrm(ks[7], (DEPTH, D), 0.05),
        'w_out': nrm(ks[8], (DEPTH, MIX, D), MIX ** -0.5),
        'ab_w_in': nrm(ks[9], (N_EVEN, D, 2 * D_A + 2 * D_B), D ** -0.5),
        'a_dw_w': nrm(ks[10], (N_EVEN, CONV_A, D_A), CONV_A ** -0.5),
        'a_dw_b': nrm(ks[11], (N_EVEN, D_A), 0.01),
        'a_ln_g': 1.0 + nrm(ks[12], (N_EVEN, D_A), 0.05),
        'a_ln_b': nrm(ks[13], (N_EVEN, D_A), 0.01),
        'b_conv_w': nrm(ks[14], (N_EVEN, CONV_B, D_B), CONV_B ** -0.5),
        'b_conv_b': nrm(ks[15], (N_EVEN, D_B), 0.01),
        'b_gate_w': nrm(ks[16], (N_EVEN, 2, 2, N_LRU_BLOCKS, LRU_BLOCK, LRU_BLOCK), LRU_BLOCK ** -0.5),
        'b_gate_b': nrm(ks[18], (N_EVEN, 2, 2, D_B), 0.01),
        'b_lambda': b_lambda,
        'cd_w_in': nrm(ks[19], (N_ODD, D, 3 * D_C + 3 * D_D), D ** -0.5),
        'c_conv_w': nrm(ks[20], (N_ODD, CONV_C, D_C), CONV_C ** -0.5),
        'd_rpb': nrm(ks[21], (N_ODD, N_HEADS_D, 2 * WIN_H - 1, 2 * WIN_W - 1), 0.1),
        'router_w': nrm(ks[22], (D, N_EXPERTS), D ** -0.5),
        'router_bias': nrm(ks[23], (N_EXPERTS,), 0.01),
        'moe_w_gate': nrm(ks[24], (DEPTH, N_EXPERTS, D, D_FF), D ** -0.5),
        'moe_w_up': nrm(ks[25], (DEPTH, N_EXPERTS, D, D_FF), D ** -0.5),
        'moe_w_down': nrm(ks[26], (DEPTH, N_EXPERTS, D_FF, D), D_FF ** -0.5),
        'final_g': 1.0 + nrm(ks[27], (D,), 0.05),
    }


def reference(x, c, ctx, c_ctx, ada_w, ada_b, norm_mix_g, norm_ffn_g, w_out,
              ab_w_in, a_dw_w, a_dw_b, a_ln_g, a_ln_b, b_conv_w, b_conv_b, b_gate_w, b_gate_b, b_lambda,
              cd_w_in, c_conv_w, d_rpb, router_w, router_bias, moe_w_gate, moe_w_up, moe_w_down, final_g):
    h_lat, h_ctx = x, ctx
    cond_lat = jax.nn.silu(c)
    cond_ctx = jax.nn.silu(c_ctx)[None]
    for layer in range(DEPTH):
        with_ctx = layer < DEPTH - 1
        j = layer // 2
        mod_l = (cond_lat @ ada_w[layer] + ada_b[layer])[:, None, :]
        mod_c = (cond_ctx @ ada_w[layer] + ada_b[layer])[:, None, :]
        sh1_l, sc1_l, g1_l, sh2_l, sc2_l, g2_l = jnp.split(mod_l, 6, -1)
        sh1_c, sc1_c, g1_c, sh2_c, sc2_c, g2_c = jnp.split(mod_c, 6, -1)
        n_lat = rms_norm(h_lat, norm_mix_g[layer]) * (1.0 + sc1_l) + sh1_l
        n_ctx = rms_norm(h_ctx, norm_mix_g[layer]) * (1.0 + sc1_c) + sh1_c
        if layer % 2 == 0:
            m_lat, m_ctx = mixer_conv_lru(n_lat, n_ctx, ab_w_in[j], a_dw_w[j], a_dw_b[j], a_ln_g[j], a_ln_b[j],
                                          b_conv_w[j], b_conv_b[j], b_gate_w[j], b_gate_b[j], b_lambda[j], with_ctx)
        else:
            m_lat, m_ctx = mixer_conv_natten(n_lat, n_ctx, cd_w_in[j], c_conv_w[j], d_rpb[j], with_ctx)
        h_lat = h_lat + g1_l * (m_lat @ w_out[layer])
        f_lat = moe(rms_norm(h_lat, norm_ffn_g[layer]) * (1.0 + sc2_l) + sh2_l,
                    router_w, router_bias, moe_w_gate[layer], moe_w_up[layer], moe_w_down[layer])
        h_lat = h_lat + g2_l * f_lat
        if with_ctx:
            h_ctx = h_ctx + g1_c * (m_ctx @ w_out[layer])
            f_ctx = moe(rms_norm(h_ctx, norm_ffn_g[layer]) * (1.0 + sc2_c) + sh2_c,
                        router_w, router_bias, moe_w_gate[layer], moe_w_up[layer], moe_w_down[layer])
            h_ctx = h_ctx + g2_c * f_ctx
    return rms_norm(h_lat, final_g)
```

```cpp
#include <hip/hip_runtime.h>
#include <cstdio>
#include <cstdint>

#ifndef MK_N_LAUNCHES
#define MK_N_LAUNCHES 1
#endif

#define LAS __attribute__((address_space(3)))
#define GAS __attribute__((address_space(1)))
typedef unsigned short bf16;
typedef unsigned v4u __attribute__((ext_vector_type(4)));
typedef unsigned v2u __attribute__((ext_vector_type(2)));
typedef float f32x4 __attribute__((ext_vector_type(4)));
typedef float f32x2 __attribute__((ext_vector_type(2)));
typedef short bf16x8 __attribute__((ext_vector_type(8)));

constexpr int D = 1024, NBATCH = 2, SEQ = 8192, CTXL = 256;
constexpr int MLAT = NBATCH * SEQ;
constexpr int MCTX = NBATCH * CTXL;
constexpr int MALL = MLAT + MCTX;
constexpr int NEXP = 16, DFF = 512, CAP = MALL;
constexpr int GRIDW = 64, NROWS = SEQ / GRIDW;
constexpr float EPS = 1e-6f;
constexpr int NPH = 17;

constexpr size_t MiB = 1u << 20;
constexpr size_t WS_CTL = 0, CTL_ZERO_BYTES = 1 * MiB;
constexpr size_t WS_MOD = 1 * MiB;
constexpr size_t WS_SUM = 2 * MiB;
constexpr size_t WS_LIST = 5 * MiB;
constexpr size_t WS_RSLOT = 8 * MiB;
constexpr size_t WS_RW = 8 * MiB + 512 * 1024;
constexpr size_t WS_WAB = 10 * MiB;
constexpr size_t WS_WOUT = 14 * MiB;
constexpr size_t WS_WCD = 18 * MiB;
constexpr size_t WS_WGU = 24 * MiB;
constexpr size_t WS_WD = 88 * MiB;
constexpr size_t WS_XN = 120 * MiB;
constexpr size_t WS_H = 153 * MiB;
constexpr size_t WS_P = 219 * MiB;
constexpr int YROWS = 37632;
constexpr size_t WS_Y = WS_P, WS_HID = WS_P + (size_t)YROWS * 1024 * 2;
constexpr size_t WS_END = 330 * MiB;
static_assert(WS_HID + (size_t)YROWS * 512 * 2 <= WS_END, "ws map");
static_assert(WS_P + (size_t)MALL * 3072 * 2 <= WS_END, "ws map");
constexpr int CW_BAR = 4096;
constexpr int CW_CNT = 16384;

constexpr int RING_BYTES = 131072;
constexpr int LDSCTL_OFF = RING_BYTES, MISC_OFF = LDSCTL_OFF + 320, TS_OFF = LDSCTL_OFF + 1024;
constexpr int LDS_BYTES = 147456;
constexpr int NWAVES = 8;

__device__ __forceinline__ float bf2f(bf16 b) { return __uint_as_float((unsigned)b << 16); }
__device__ __forceinline__ unsigned f2bf(float f) { unsigned u = __builtin_bit_cast(unsigned, f); return (u + 0x7fffu + ((u >> 16) & 1u)) >> 16; }
__device__ __forceinline__ unsigned pk2(float lo, float hi) { return f2bf(lo) | (f2bf(hi) << 16); }
__device__ __forceinline__ float sigm(float x) { return 1.f / (1.f + __expf(-x)); }
__device__ __forceinline__ float gelu_tanh(float x) { const float u = 0.7978845608028654f * (x + 0.044715f * x * x * x); return x * sigm(2.f * u); }
__device__ __forceinline__ float wave_sum(float v) {
#pragma unroll
    for (int o = 1; o < 64; o <<= 1) v += __shfl_xor(v, o);
    return v;
}
#define LDS_WAIT() asm volatile("s_waitcnt lgkmcnt(0)" ::: "memory")
#define RLX_AGENT __ATOMIC_RELAXED, __HIP_MEMORY_SCOPE_AGENT

namespace pg8 {
typedef unsigned short bf16_t;
typedef unsigned u32x4 __attribute__((ext_vector_type(4)));
constexpr int BM = 256, BK = 64, HALF = 128, HTB = HALF * BK * 2, STAGE_BYTES = 8 * HTB, NXCD = 8, WGM = 8;
__host__ __device__ __forceinline__ int lds_byte(int r, int c) { const int st = (r >> 4) * 2 + (c >> 5), rr = r & 15, cc = c & 31, ob = rr * 64 + cc * 2; return st * 1024 + (ob ^ (((ob >> 9) & 1) << 5)); }
__host__ __device__ __forceinline__ void stage_rc(int b, int& R, int& C) { const int st = b / 1024, sb = b % 1024, swz = sb ^ (((sb >> 9) & 1) << 5); R = (st >> 1) * 16 + swz / 64; C = (st & 1) * 32 + (swz % 64) / 2; }
__host__ __device__ __forceinline__ int perm32(int rho) { const int n = rho >> 4, i = rho & 15; return 8 * (i >> 2) + 4 * n + (i & 3); }

struct Unit { int pm, pn, e, r0, cnt; };

struct StaticOrder {
    int nM, nN, nwg, G, c;
    __device__ void init(int nM_, int nN_, int G_, int c_) { nM = nM_; nN = nN_; nwg = nM * nN; G = G_; c = c_; }
    __device__ bool next(int i, Unit& u) const {
        const long L = (long)i * G + c; if (L >= nwg) return false;
        int wgid = (int)L; { const int q = nwg / NXCD, r = nwg % NXCD, xcd = wgid % NXCD, off = wgid / NXCD; wgid = (xcd < r ? xcd * (q + 1) : r * (q + 1) + (xcd - r) * q) + off; }
        const int nig = WGM * nN, gid = wgid / nig, fm = gid * WGM, gsz = (nM - fm) < WGM ? (nM - fm) : WGM;
        u.pm = fm + ((wgid % nig) % gsz); u.pn = (wgid % nig) / gsz; u.e = 0; u.r0 = 0; u.cnt = 0; return true;
    }
};
struct SchedPlain {
    static constexpr bool GATHER = false;
    StaticOrder so; const char* A; const char* B; size_t tstep;
    __device__ __forceinline__ bool next(int i, Unit& u) const { return so.next(i, u); }
    __device__ __forceinline__ const char* a_ptr(const Unit& u) const { return A + (size_t)u.pm * tstep; }
    __device__ __forceinline__ const char* b_ptr(const Unit& u) const { return B + (size_t)u.pn * tstep; }
    __device__ __forceinline__ void a_offs(const Unit&, const int (&)[2], const int (&)[2], int, unsigned (&)[2][2]) const {}
};
struct SchedMoe {
    StaticOrder so; const LAS int* ts;
    __device__ __forceinline__ bool next(int i, Unit& u) const {
        if (!so.next(i, u)) return false;
        int e = 0;
#pragma unroll
        for (int j = 1; j < 16; ++j) e += (ts[j] <= u.pm) ? 1 : 0;
        e = __builtin_amdgcn_readfirstlane(e);
        u.e = e; u.r0 = (u.pm - __builtin_amdgcn_readfirstlane(ts[e])) * 256; u.cnt = __builtin_amdgcn_readfirstlane(ts[17 + e]); return true;
    }
};
struct SchedMoeGU : SchedMoe {
    static constexpr bool GATHER = true;
    const char* A; const char* B; const int* list;
    __device__ __forceinline__ const char* a_ptr(const Unit&) const { return A; }
    __device__ __forceinline__ const char* b_ptr(const Unit& u) const { return B + (size_t)u.e * (1024 * 1024 * 2) + (size_t)u.pn * (256 * 1024 * 2); }
    __device__ __forceinline__ void a_offs(const Unit& u, const int (&R)[2], const int (&C)[2], int K, unsigned (&v)[2][2]) const {
#pragma unroll
        for (int h = 0; h < 2; ++h)
#pragma unroll
            for (int i = 0; i < 2; ++i) { const int row = u.r0 + h * HALF + R[i]; int tok = 0; if (row < u.cnt) tok = list[u.e * CAP + row]; v[h][i] = (unsigned)(tok * K + C[i]) * 2u; }
    }
};
struct SchedMoeDown : SchedMoe {
    static constexpr bool GATHER = false;
    const char* A; const char* B;
    __device__ __forceinline__ const char* a_ptr(const Unit& u) const { return A + (size_t)u.pm * (256 * 512 * 2); }
    __device__ __forceinline__ const char* b_ptr(const Unit& u) const { return B + (size_t)u.e * (1024 * 512 * 2) + (size_t)u.pn * (256 * 512 * 2); }
    __device__ __forceinline__ void a_offs(const Unit&, const int (&)[2], const int (&)[2], int, unsigned (&)[2][2]) const {}
};

__device__ __forceinline__ unsigned cvt_pk_bf16(float lo, float hi) { unsigned r; asm volatile("v_cvt_pk_bf16_f32 %0, %1, %2" : "=v"(r) : "v"(lo), "v"(hi)); return r; }
struct EpiBf16 {
    static constexpr bool PERM = true;
    bf16_t* O; int ldc;
    __device__ __forceinline__ void operator()(const f32x4 (&acc)[2][2][4][2], const Unit& u, int wr, int wc, int fr, int fq) const {
        const int row0 = u.pm * BM + wr * 64 + fr, col0 = u.pn * BM + wc * 32 + 8 * fq;
#pragma unroll
        for (int ai = 0; ai < 2; ++ai)
#pragma unroll
            for (int m = 0; m < 4; ++m) { bf16_t* rowp = O + (size_t)(row0 + ai * HALF + m * 16) * ldc + col0;
#pragma unroll
                for (int bj = 0; bj < 2; ++bj) { const f32x4 v0 = acc[ai][bj][m][0], v1 = acc[ai][bj][m][1];
                    u32x4 w; w.x = cvt_pk_bf16(v0[0], v0[1]); w.y = cvt_pk_bf16(v0[2], v0[3]); w.z = cvt_pk_bf16(v1[0], v1[1]); w.w = cvt_pk_bf16(v1[2], v1[3]);
                    *(u32x4*)(rowp + bj * HALF) = w; } }
    }
};
struct EpiRes {
    static constexpr bool PERM = false;
    const float* hin_lat; const float* hin_ctx; float* hout; const float* gate;
    __device__ __forceinline__ void operator()(const f32x4 (&acc)[2][2][4][2], const Unit& u, int wr, int wc, int fr, int fq) const {
        const int row0 = u.pm * BM + wr * 64 + fr, col0 = u.pn * BM + wc * 32 + 4 * fq;
        const int mi = (u.pm >> 5) > 2 ? 2 : (u.pm >> 5);
        const float* src = (u.pm < 64) ? hin_lat : hin_ctx;
        f32x4 gv[2][2];
#pragma unroll
        for (int bj = 0; bj < 2; ++bj)
#pragma unroll
            for (int n = 0; n < 2; ++n) gv[bj][n] = *(const f32x4*)(gate + mi * 6144 + col0 + bj * HALF + n * 16);
#pragma unroll
        for (int ai = 0; ai < 2; ++ai)
#pragma unroll
            for (int m = 0; m < 4; ++m) { const size_t off = (size_t)(row0 + ai * HALF + m * 16) * D + col0;
#pragma unroll
                for (int bj = 0; bj < 2; ++bj)
#pragma unroll
                    for (int n = 0; n < 2; ++n) { const f32x4 b = *(const f32x4*)(src + off + bj * HALF + n * 16); *(f32x4*)(hout + off + bj * HALF + n * 16) = b + gv[bj][n] * acc[ai][bj][m][n]; } }
    }
};
struct EpiGateUp {
    static constexpr bool PERM = true;
    bf16_t* Hd;
    __device__ __forceinline__ void operator()(const f32x4 (&acc)[2][2][4][2], const Unit& u, int wr, int wc, int fr, int fq) const {
        const int row0 = u.pm * BM + wr * 64 + fr, col0 = u.pn * HALF + wc * 32 + 8 * fq;
#pragma unroll
        for (int ai = 0; ai < 2; ++ai)
#pragma unroll
            for (int m = 0; m < 4; ++m) { bf16_t* rowp = Hd + (size_t)(row0 + ai * HALF + m * 16) * DFF + col0;
                float h[8];
#pragma unroll
                for (int n = 0; n < 2; ++n)
#pragma unroll
                    for (int j = 0; j < 4; ++j) { const float g = acc[ai][0][m][n][j], up = acc[ai][1][m][n][j]; h[n * 4 + j] = g * sigm(g) * up; }
                u32x4 w; w.x = cvt_pk_bf16(h[0], h[1]); w.y = cvt_pk_bf16(h[2], h[3]); w.z = cvt_pk_bf16(h[4], h[5]); w.w = cvt_pk_bf16(h[6], h[7]);
                *(u32x4*)rowp = w; }
    }
};

template <class Epi, class Sched, bool ALIGN_EPI, bool SP2>
__device__ __forceinline__ void gemm_phase(LAS unsigned char* lds, const int K, const Sched& S, const Epi& E) {
    const int tid = threadIdx.x, wid = __builtin_amdgcn_readfirstlane(tid >> 6), lane = tid & 63, wr = wid >> 2, wc = wid & 3, fr = lane & 15, fq = lane >> 4;
    const int nt = K / BK;
    const size_t kstep = (size_t)(BK * 2);
    const size_t hstep = (size_t)HALF * K * 2;
    int Rr[2], Cc[2]; unsigned voffB[2], vA[2][2], nvA[2][2];
#pragma unroll
    for (int i = 0; i < 2; ++i) { int R, C; stage_rc(tid * 16 + i * 8192, R, C); Rr[i] = R; Cc[i] = C; const int Rb = Epi::PERM ? ((R & ~31) + perm32(R & 31)) : R;
        voffB[i] = (unsigned)(Rb * K + C) * 2u; vA[0][i] = (unsigned)(R * K + C) * 2u; vA[1][i] = vA[0][i] + (unsigned)hstep; nvA[0][i] = vA[0][i]; nvA[1][i] = vA[1][i]; }
    const unsigned ldsw = (unsigned)wid * 1024u;
    const int aoff = lds_byte(wr * 64 + fr, fq * 8), boff = lds_byte(wc * 32 + fr, fq * 8);
#define PG8_SA(b, h) (((b) * 2 + (h)) * HTB)
#define PG8_SB(b, h) ((4 + (b) * 2 + (h)) * HTB)
#define PG8_STAGE(bufoff, gbase, voff) do { _Pragma("unroll") for (int _i = 0; _i < 2; ++_i) \
        __builtin_amdgcn_global_load_lds((const unsigned*)((const char*)(gbase) + (voff)[_i]), (LAS unsigned*)(lds + (bufoff) + ldsw + _i * 8192), 16, 0, 0); } while (0)
#define PG8_LDA(dst, b, h) do { _Pragma("unroll") for (int m = 0; m < 4; ++m) _Pragma("unroll") for (int k = 0; k < 2; ++k) dst[m][k] = *(const LAS bf16x8*)(lds + PG8_SA(b, h) + aoff + m * 2048 + k * 1024); } while (0)
#define PG8_LDB(dst, b, h) do { _Pragma("unroll") for (int n = 0; n < 2; ++n) _Pragma("unroll") for (int k = 0; k < 2; ++k) dst[n][k] = *(const LAS bf16x8*)(lds + PG8_SB(b, h) + boff + n * 2048 + k * 1024); } while (0)
#define PG8_MMA(ai, bj, At, Bt) do { __builtin_amdgcn_s_setprio(1); _Pragma("unroll") for (int m = 0; m < 4; ++m) _Pragma("unroll") for (int n = 0; n < 2; ++n) _Pragma("unroll") for (int k = 0; k < 2; ++k) \
        acc[ai][bj][m][n] = __builtin_amdgcn_mfma_f32_16x16x32_bf16(Bt[n][k], At[m][k], acc[ai][bj][m][n], 0, 0, 0); __builtin_amdgcn_s_setprio(0); } while (0)
#define PG8_WAIT_V(n) asm volatile("s_waitcnt vmcnt(" #n ")" ::: "memory")
#define PG8_WAIT_L(n) asm volatile("s_waitcnt lgkmcnt(" #n ")" ::: "memory")
#define PG8_BAR __builtin_amdgcn_s_barrier()
#define PG8_SCHED __builtin_amdgcn_sched_barrier(0)
    Unit cur, nxt; int ui = 0;
    if (!S.next(0, cur)) return;
    if constexpr (Sched::GATHER) { S.a_offs(cur, Rr, Cc, K, vA); }
    f32x4 acc[2][2][4][2];
#pragma unroll
    for (int a = 0; a < 2; ++a)
#pragma unroll
        for (int b = 0; b < 2; ++b)
#pragma unroll
            for (int m = 0; m < 4; ++m)
#pragma unroll
                for (int n = 0; n < 2; ++n) acc[a][b][m][n] = (f32x4){0.f, 0.f, 0.f, 0.f};
    bf16x8 At[4][2], B0[2][2], B1[2][2];
    const char* cA = S.a_ptr(cur); const char* cB = S.b_ptr(cur);
    static_assert(SP2, "only the two-super-phase loop is kept");
    PG8_STAGE(PG8_SB(0, 0), cB, voffB); PG8_STAGE(PG8_SB(0, 1), cB + hstep, voffB); PG8_STAGE(PG8_SA(0, 0), cA, vA[0]); PG8_STAGE(PG8_SA(0, 1), cA, vA[1]);
    if (wr == 1) PG8_BAR;
    PG8_WAIT_V(2); PG8_BAR;
    PG8_STAGE(PG8_SB(1, 0), cB + kstep, voffB); PG8_STAGE(PG8_SA(1, 0), cA + kstep, vA[0]); PG8_STAGE(PG8_SB(1, 1), cB + hstep + kstep, voffB);
    PG8_WAIT_V(6); PG8_BAR;
    for (;;) {
        const bool has_next = S.next(ui + 1, nxt);
        const char* nA = has_next ? S.a_ptr(nxt) : cA; const char* nB = has_next ? S.b_ptr(nxt) : cB;
        if constexpr (Sched::GATHER) { if (has_next) S.a_offs(nxt, Rr, Cc, K, nvA); }
        for (int t = 0; t < nt; t += 2) {
            const bool last = (t == nt - 2);
            const char* a1 = cA + (size_t)(t + 1) * kstep;
            const char* a2 = last ? nA : cA + (size_t)(t + 2) * kstep; const char* b2 = last ? nB : cB + (size_t)(t + 2) * kstep;
            const char* a3 = a2 + kstep; const char* b3 = b2 + kstep;
            unsigned wA[2][2];
#pragma unroll
            for (int h = 0; h < 2; ++h)
#pragma unroll
                for (int i = 0; i < 2; ++i) wA[h][i] = (Sched::GATHER && last) ? nvA[h][i] : vA[h][i];
            PG8_LDB(B0, 0, 0); PG8_LDB(B1, 0, 1); PG8_SCHED; PG8_LDA(At, 0, 0); PG8_STAGE(PG8_SA(1, 1), a1, vA[1]);
            PG8_WAIT_V(8); PG8_WAIT_L(0); PG8_BAR; PG8_MMA(0, 0, At, B0); PG8_MMA(0, 1, At, B1); PG8_BAR; PG8_SCHED;
            PG8_LDA(At, 0, 1); PG8_STAGE(PG8_SB(0, 0), b2, voffB); PG8_STAGE(PG8_SB(0, 1), b2 + hstep, voffB); PG8_STAGE(PG8_SA(0, 0), a2, wA[0]);
            PG8_WAIT_V(8); PG8_WAIT_L(0); PG8_BAR; PG8_MMA(1, 0, At, B0); PG8_MMA(1, 1, At, B1); PG8_BAR; PG8_SCHED;
            PG8_LDB(B0, 1, 0); PG8_LDB(B1, 1, 1); PG8_SCHED; PG8_LDA(At, 1, 0); PG8_STAGE(PG8_SA(0, 1), a2, wA[1]);
            PG8_WAIT_V(8); PG8_WAIT_L(0); PG8_BAR; PG8_MMA(0, 0, At, B0); PG8_MMA(0, 1, At, B1); PG8_BAR; PG8_SCHED;
            PG8_LDA(At, 1, 1); PG8_STAGE(PG8_SB(1, 0), b3, voffB); PG8_STAGE(PG8_SB(1, 1), b3 + hstep, voffB); PG8_STAGE(PG8_SA(1, 0), a3, wA[0]);
            PG8_WAIT_V(8); PG8_WAIT_L(0); PG8_BAR; PG8_MMA(1, 0, At, B0); PG8_MMA(1, 1, At, B1); PG8_BAR; PG8_SCHED;
        }
        if constexpr (ALIGN_EPI) { if (wr == 0) PG8_BAR; }
        E(acc, cur, wr, wc, fr, fq);
        if (!has_next) break;
#pragma unroll
        for (int a = 0; a < 2; ++a)
#pragma unroll
            for (int b = 0; b < 2; ++b)
#pragma unroll
                for (int m = 0; m < 4; ++m)
#pragma unroll
                    for (int n = 0; n < 2; ++n) acc[a][b][m][n] = (f32x4){0.f, 0.f, 0.f, 0.f};
        cur = nxt; cA = nA; cB = nB; ++ui;
        if constexpr (Sched::GATHER) {
#pragma unroll
            for (int h = 0; h < 2; ++h)
#pragma unroll
                for (int i = 0; i < 2; ++i) vA[h][i] = nvA[h][i];
        }
        if constexpr (ALIGN_EPI) { if (wr == 1) PG8_BAR; }
    }
    PG8_WAIT_V(0);
    if constexpr (!ALIGN_EPI) { if (wr == 0) PG8_BAR; }
    PG8_BAR;
#undef PG8_SA
#undef PG8_SB
#undef PG8_STAGE
#undef PG8_LDA
#undef PG8_LDB
#undef PG8_MMA
#undef PG8_WAIT_V
#undef PG8_WAIT_L
#undef PG8_BAR
#undef PG8_SCHED
}
}

typedef GAS unsigned gu32;
#define XB_TMO      128
#define XB_XCNT(j)  (256  + 64 * (j))
#define XB_XSUB(j)  (1280 + 64 * (j))
#define XB_XGEN(j)  (2304 + 64 * (j))
#define XB_TOP      3328
#define XB_TOPGEN   3392
#define XCD_BAR_WORDS 3456
#define XB_SPIN_CAP (1u << 20)
__device__ __forceinline__ unsigned xb_ld(unsigned* p)              { return __hip_atomic_load(p, __ATOMIC_RELAXED, __HIP_MEMORY_SCOPE_AGENT); }
__device__ __forceinline__ unsigned xb_add(unsigned* p, unsigned v) { return __hip_atomic_fetch_add(p, v, __ATOMIC_RELAXED, __HIP_MEMORY_SCOPE_AGENT); }
__device__ __forceinline__ unsigned xb_xcc_id() { return (unsigned)__builtin_amdgcn_s_getreg((3 << 11) | 20) & 0xFu; }
#define XB_SPIN(cond, bar) do { unsigned _sp = 0; while (cond) { __builtin_amdgcn_s_sleep(1); \
    if ((++_sp & 255u) == 0u) { if (xb_ld(&(bar)[XB_TMO])) break; if (_sp > XB_SPIN_CAP) { atomicAdd(&(bar)[XB_TMO], 1u); break; } } } } while (0)
struct XcdBarrier { unsigned* bar; unsigned x; volatile LAS unsigned* st; };
__device__ __forceinline__ XcdBarrier xcd_barrier_post(unsigned* bar, volatile LAS unsigned* st) {
    XcdBarrier b; b.bar = bar; b.x = xb_xcc_id(); b.st = st;
    if (threadIdx.x == 0) (void)xb_add(&bar[XB_XCNT(b.x)], 1u);
    return b;
}
__device__ __forceinline__ void xcd_barrier_complete(unsigned* bar, unsigned x, unsigned& nloc, unsigned& nx) {
    const unsigned G = gridDim.x * gridDim.y * gridDim.z;
    unsigned sum, cnt, mine, sp = 0u;
    for (;;) {
        sum = 0u; cnt = 0u; mine = 0u;
#pragma unroll
        for (unsigned j = 0; j < 16; ++j) { const unsigned c = xb_ld(&bar[XB_XCNT(j)]); sum += c; cnt += (c > 0u) ? 1u : 0u; mine = (j == x) ? c : mine; }
        if (sum == G) break;
        __builtin_amdgcn_s_sleep(1);
        if ((++sp & 255u) == 0u) { if (xb_ld(&bar[XB_TMO])) break; if (sp > XB_SPIN_CAP) { atomicAdd(&bar[XB_TMO], 1u); break; } }
    }
    nloc = mine > 0u ? mine : 1u; nx = cnt > 0u ? cnt : 1u;
}
__device__ __forceinline__ void xcd_barrier(const XcdBarrier& b) {
    asm volatile("s_waitcnt vmcnt(0)" ::: "memory");
    __syncthreads();
    if (threadIdx.x == 0) {
        unsigned* bar = b.bar;
        __builtin_amdgcn_s_waitcnt(0);
        unsigned nloc = b.st[0], nx = b.st[1];
        if (nloc == 0u) { xcd_barrier_complete(bar, b.x, nloc, nx); b.st[0] = nloc; b.st[1] = nx; }
        const unsigned old = xb_add(&bar[XB_XSUB(b.x)], 1u);
        const unsigned gen = old / nloc;
        if (old + 1u == (gen + 1u) * nloc) {
            __builtin_amdgcn_fence(__ATOMIC_RELEASE, "agent");
            asm volatile("s_waitcnt vmcnt(0)" ::: "memory");
            const unsigned og = xb_add(&bar[XB_TOP], 1u);
            const unsigned tg = og / nx;
            if (og + 1u == (tg + 1u) * nx) xb_add(&bar[XB_TOPGEN], 1u);
            else XB_SPIN(xb_ld(&bar[XB_TOPGEN]) == tg, bar);
            __builtin_amdgcn_fence(__ATOMIC_ACQUIRE, "agent");
            xb_add(&bar[XB_XGEN(b.x)], 1u);
            asm volatile("s_waitcnt vmcnt(0)" ::: "memory");
        } else {
            XB_SPIN(xb_ld(&bar[XB_XGEN(b.x)]) == gen, bar);
            __builtin_amdgcn_fence(__ATOMIC_ACQUIRE, "agent");
            asm volatile("s_waitcnt vmcnt(0)" ::: "memory");
        }
    }
    __syncthreads();
}

struct Frame {
    LAS unsigned char* lds;
    volatile LAS unsigned* MISC;
    gu32* ctl;
    int tid, lane, wave, vcu, G;
    const float *x, *c, *ctx, *c_ctx, *ada_w, *ada_b, *gmix, *gffn, *w_out, *ab_w_in, *a_dw_w, *a_dw_b, *a_ln_g, *a_ln_b, *b_conv_w, *b_conv_b, *b_gate_w, *b_gate_b, *b_lambda,
        *cd_w_in, *c_conv_w, *d_rpb, *router_w, *router_bias, *moe_wg, *moe_wu, *moe_wd, *final_g;
    float* out;
    float* mod; float* sum; int* list; int* rslot; float* rw;
    bf16 *Wab, *Wout, *Wcd, *Wgu, *Wd;
    bf16 *XN, *P, *Y, *HID; float* H;
};

__device__ __forceinline__ void p0_transpose_item(const float* W, int K, int N, bf16* WT, int rbase, int rstride, LAS float* scr, int item, int lane) {
    const int nblk = N / 32, kb = item / nblk, nb = item % nblk, k0 = 64 * kb, n0 = 32 * nb;
    const int orow0 = rbase + (n0 >> 7) * rstride + (n0 & 127);
#pragma unroll 8
    for (int i = 0; i < 32; ++i) { const int kk = 2 * i + (lane >> 5); scr[kk * 33 + (lane & 31)] = W[(size_t)(k0 + kk) * N + n0 + (lane & 31)]; }
    LDS_WAIT(); asm volatile("" ::: "memory");
    const int c = lane & 7;
#pragma unroll
    for (int j = 0; j < 4; ++j) { const int n = (lane >> 3) + 8 * j; const LAS float* s = scr + (8 * c) * 33 + n;
        v4u o; o.x = pk2(s[0 * 33], s[1 * 33]); o.y = pk2(s[2 * 33], s[3 * 33]); o.z = pk2(s[4 * 33], s[5 * 33]); o.w = pk2(s[6 * 33], s[7 * 33]);
        *(GAS v4u*)(WT + (size_t)(orow0 + n) * K + k0 + 8 * c) = o; }
    LDS_WAIT(); asm volatile("" ::: "memory");
}

__device__ __forceinline__ void p0_prologue(Frame& F) {
    LAS float* condL = (LAS float*)F.lds;
    LAS float* red = condL + 3 * 1024;
    for (int i = F.tid; i < 3072; i += NWAVES * 64) { const int m = i >> 10, k = i & 1023; const float cv = (m < 2) ? F.c[m * 1024 + k] : F.c_ctx[k]; condL[i] = cv * sigm(cv); }
    __syncthreads();
    if (blockIdx.x < 192) {
        const int cg = blockIdx.x, layer = cg / 96, col0 = (cg % 96) * 64;
        const float* W = F.ada_w + (size_t)layer * 1024 * 6144 + col0 + F.lane;
        const int k0 = F.wave * 128;
        float a0 = 0.f, a1 = 0.f, a2 = 0.f;
#pragma unroll 8
        for (int kk = 0; kk < 128; ++kk) { const int k = k0 + kk; const float w = W[(size_t)k * 6144]; a0 += condL[k] * w; a1 += condL[1024 + k] * w; a2 += condL[2048 + k] * w; }
        red[(F.wave * 3 + 0) * 64 + F.lane] = a0; red[(F.wave * 3 + 1) * 64 + F.lane] = a1; red[(F.wave * 3 + 2) * 64 + F.lane] = a2;
        __syncthreads();
        if (F.tid < 192) { const int m = F.tid >> 6, l = F.tid & 63; float s = 0.f;
#pragma unroll
            for (int w = 0; w < 8; ++w) s += red[(w * 3 + m) * 64 + l];
            F.mod[(layer * 3 + m) * 6144 + col0 + l] = s + F.ada_b[layer * 6144 + col0 + l]; }
    }
    __syncthreads();
    LAS float* scr = (LAS float*)(F.lds + F.wave * 16384);
    const int gw = F.vcu * NWAVES + F.wave, NGW = F.G * NWAVES;
    constexpr int I_AB = 16 * 64, I_OUT = 16 * 32, I_CD = 16 * 96, I_G = 16 * 16, I_DN = 8 * 32;
    constexpr int NITEMS = I_AB + 2 * I_OUT + I_CD + 32 * (2 * I_G + I_DN);
    for (int it = gw; it < NITEMS; it += NGW) {
        int r = it;
        if (r < I_AB) { p0_transpose_item(F.ab_w_in, 1024, 2048, F.Wab, 0, 128, scr, r, F.lane); continue; } r -= I_AB;
        if (r < 2 * I_OUT) { const int l = r / I_OUT; p0_transpose_item(F.w_out + (size_t)l * 1024 * 1024, 1024, 1024, F.Wout + (size_t)l * 1024 * 1024, 0, 128, scr, r % I_OUT, F.lane); continue; } r -= 2 * I_OUT;
        if (r < I_CD) { p0_transpose_item(F.cd_w_in, 1024, 3072, F.Wcd, 0, 128, scr, r, F.lane); continue; } r -= I_CD;
        if (r < 32 * I_G) { const int le = r / I_G; p0_transpose_item(F.moe_wg + (size_t)le * 1024 * 512, 1024, 512, F.Wgu + (size_t)le * 1024 * 1024, 0, 256, scr, r % I_G, F.lane); continue; } r -= 32 * I_G;
        if (r < 32 * I_G) { const int le = r / I_G; p0_transpose_item(F.moe_wu + (size_t)le * 1024 * 512, 1024, 512, F.Wgu + (size_t)le * 1024 * 1024, 128, 256, scr, r % I_G, F.lane); continue; } r -= 32 * I_G;
        { const int le = r / I_DN; p0_transpose_item(F.moe_wd + (size_t)le * 512 * 1024, 512, 1024, F.Wd + (size_t)le * 1024 * 512, 0, 128, scr, r % I_DN, F.lane); }
    }
}

__device__ __forceinline__ void norm_mod_store(const f32x4 (&v)[4], const float* g, const float* sc, const float* sh, bf16* dst, int lane, f32x4 (&t)[4]) {
    float s = 0.f;
#pragma unroll
    for (int j = 0; j < 4; ++j) s += (v[j].x * v[j].x + v[j].y * v[j].y) + (v[j].z * v[j].z + v[j].w * v[j].w);
    const float rstd = 1.f / sqrtf(wave_sum(s) * (1.f / D) + EPS);
#pragma unroll
    for (int j = 0; j < 4; ++j) { const int col = 4 * lane + 256 * j;
        const f32x4 gg = *(const f32x4*)(g + col), ss = *(const f32x4*)(sc + col), hh = *(const f32x4*)(sh + col);
        t[j] = v[j] * rstd * gg * (ss + 1.0f) + hh;
        v2u o; o.x = pk2(t[j].x, t[j].y); o.y = pk2(t[j].z, t[j].w);
        *(v2u*)(dst + col) = o; }
}

__device__ __forceinline__ void p1_norm0(Frame& F) {
    const int gw = F.vcu * NWAVES + F.wave, NGW = F.G * NWAVES;
    for (int row = gw; row < MALL; row += NGW) {
        const float* src = (row < MLAT) ? F.x + (size_t)row * D : F.ctx + (size_t)(row - MLAT) * D;
        const int mi = (row >> 13) > 2 ? 2 : (row >> 13);
        f32x4 v[4], t[4];
#pragma unroll
        for (int j = 0; j < 4; ++j) v[j] = *(const f32x4*)(src + 4 * F.lane + 256 * j);
        const float* md = F.mod + (0 * 3 + mi) * 6144;
        norm_mod_store(v, F.gmix, md + 1024, md, F.XN + (size_t)row * D, F.lane, t);
        if (row >= MLAT) {
#pragma unroll
            for (int j = 0; j < 4; ++j) *(f32x4*)(F.H + (size_t)row * D + 4 * F.lane + 256 * j) = v[j];
        }
    }
}

__device__ __forceinline__ void conf_unit(Frame& F, int u) {
    const int row0 = u * 32; int seq0, L;
    if (row0 < MLAT) { seq0 = (row0 >> 13) << 13; L = SEQ; } else { seq0 = MLAT + (((row0 - MLAT) >> 8) << 8); L = CTXL; }
    const int t0 = row0 - seq0, ch = F.tid;
    float uu[62];
#pragma unroll
    for (int tt = 0; tt < 62; ++tt) { const int t = t0 - 15 + tt; float val = 0.f;
        if (t >= 0 && t < L) { const bf16* p = F.P + (size_t)(seq0 + t) * 2048 + ch; const float v = bf2f(p[0]), g = bf2f(p[512]); val = v * sigm(g); }
        uu[tt] = val; }
    float o[32]; const float bias = F.a_dw_b[ch];
#pragma unroll
    for (int t = 0; t < 32; ++t) o[t] = bias;
#pragma unroll
    for (int k = 0; k < 31; ++k) { const float w = F.a_dw_w[k * 512 + ch];
#pragma unroll
        for (int t = 0; t < 32; ++t) o[t] += w * uu[t + k]; }
    LAS float* red = (LAS float*)F.lds;
    LAS float* fin = red + 512;
    float mine = 0.f;
#pragma unroll
    for (int t = 0; t < 32; ++t) { const float s = wave_sum(o[t]), q = wave_sum(o[t] * o[t]); mine = (F.lane == t) ? s : mine; mine = (F.lane == 32 + t) ? q : mine; }
    red[F.wave * 64 + F.lane] = mine;
    __syncthreads();
    if (F.tid < 64) { float s = 0.f;
#pragma unroll
        for (int w = 0; w < 8; ++w) s += red[w * 64 + F.tid];
        fin[F.tid] = s; }
    __syncthreads();
    const float lg = F.a_ln_g[ch], lb = F.a_ln_b[ch];
#pragma unroll
    for (int t = 0; t < 32; ++t) { const float mean = fin[t] * (1.f / 512.f); float var = fin[32 + t] * (1.f / 512.f) - mean * mean; var = var < 0.f ? 0.f : var;
        const float y = (o[t] - mean) * (1.f / sqrtf(var + EPS)) * lg + lb;
        F.XN[(size_t)(row0 + t) * D + ch] = (bf16)f2bf(y * sigm(y)); }
    __syncthreads();
}

__device__ __forceinline__ void lru_unit(Frame& F, int u, bool final) {
    const int n = u & 3, sc = u >> 2;
    int b, c, seq0, L; bool is_lat;
    if (sc < 8) { is_lat = false; b = sc >> 2; c = sc & 3; seq0 = MLAT + b * CTXL; L = CTXL; } else { is_lat = true; b = (sc - 8) >> 7; c = (sc - 8) & 127; seq0 = b * SEQ; L = SEQ; }
    const int t0 = c * 64, ch = F.tid & 127, tq = F.tid >> 7, cidx = 128 * n + ch;
    LAS float* vs = (LAS float*)F.lds;
    LAS float* sub = vs + 64 * 128;
    LAS float* cin = sub + 2048;
    float vown[16];
    {
        float uu[19];
#pragma unroll
        for (int tt = 0; tt < 19; ++tt) { const int t = t0 + tq * 16 + tt - 2; uu[tt] = (t >= 0 && t < L) ? bf2f(F.P[(size_t)(seq0 + t) * 2048 + 1024 + cidx]) : 0.f; }
        const float w0 = F.b_conv_w[cidx], w1 = F.b_conv_w[512 + cidx], w2 = F.b_conv_w[1024 + cidx], w3 = F.b_conv_w[1536 + cidx], cb = F.b_conv_b[cidx];
#pragma unroll
        for (int t = 0; t < 16; ++t) { vown[t] = cb + w0 * uu[t] + w1 * uu[t + 1] + w2 * uu[t + 2] + w3 * uu[t + 3]; vs[(tq * 16 + t) * 128 + ch] = vown[t]; }
    }
    __syncthreads();
    float acc[4][16];
#pragma unroll
    for (int m = 0; m < 4; ++m)
#pragma unroll
        for (int t = 0; t < 16; ++t) acc[m][t] = 0.f;
    const float* Wg = F.b_gate_w + (size_t)n * 16384 + ch;
    for (int k4 = 0; k4 < 128; k4 += 4) {
        float w[4][4];
#pragma unroll
        for (int m = 0; m < 4; ++m)
#pragma unroll
            for (int kk = 0; kk < 4; ++kk) w[m][kk] = Wg[(size_t)m * 65536 + (k4 + kk) * 128];
#pragma unroll
        for (int t = 0; t < 16; ++t) { const f32x4 vv = *(const LAS f32x4*)(vs + (tq * 16 + t) * 128 + k4);
#pragma unroll
            for (int m = 0; m < 4; ++m) acc[m][t] += (vv.x * w[m][0] + vv.y * w[m][1]) + (vv.z * w[m][2] + vv.w * w[m][3]); }
    }
#pragma unroll
    for (int d = 0; d < 2; ++d) {
        const float lam = F.b_lambda[d * 512 + cidx]; const float spd = log1pf(__expf(-lam));
        const float br = F.b_gate_b[(d * 2 + 0) * 512 + cidx], bi = F.b_gate_b[(d * 2 + 1) * 512 + cidx];
#pragma unroll
        for (int t = 0; t < 16; ++t) { const float r = sigm(acc[2 * d][t] + br), ii = sigm(acc[2 * d + 1][t] + bi);
            const float la = -8.0f * r * spd; const float a = __expf(la); const float bm = sqrtf(-expm1f(2.f * la));
            acc[2 * d][t] = a; acc[2 * d + 1][t] = bm * ii * vown[t]; }
    }
    { float A = 1.f, B = 0.f;
#pragma unroll
        for (int t = 0; t < 16; ++t) { B = acc[0][t] * B + acc[1][t]; A *= acc[0][t]; }
        sub[((0 * 4 + tq) * 128 + ch) * 2] = A; sub[((0 * 4 + tq) * 128 + ch) * 2 + 1] = B;
        A = 1.f; B = 0.f;
#pragma unroll
        for (int t = 15; t >= 0; --t) { B = acc[2][t] * B + acc[3][t]; A *= acc[2][t]; }
        sub[((1 * 4 + tq) * 128 + ch) * 2] = A; sub[((1 * 4 + tq) * 128 + ch) * 2 + 1] = B; }
    __syncthreads();
    if (!final) {
        if (F.tid < 256) { const int dir = F.tid >> 7; float A = 1.f, B = 0.f;
#pragma unroll
            for (int s = 0; s < 4; ++s) { const int q = dir ? 3 - s : s; const float As = sub[((dir * 4 + q) * 128 + ch) * 2], Bs = sub[((dir * 4 + q) * 128 + ch) * 2 + 1]; B = As * B + Bs; A *= As; }
            float* dst = F.sum + ((size_t)(sc * 2 + dir) * 512 + cidx) * 2; dst[0] = A; dst[1] = B; }
        __syncthreads();
        return;
    }
    if (F.tid < 256) {
        const int dir = F.tid >> 7; float h = 0.f;
        const float* sb = F.sum + ((size_t)dir * 512 + cidx) * 2;
        if (dir == 0) {
            const int nctx = is_lat ? 4 : c;
            for (int cc = 0; cc < nctx; ++cc) { const float* p = sb + (size_t)(4 * b + cc) * 2048; h = p[0] * h + p[1]; }
            if (is_lat) for (int cc = 0; cc < c; ++cc) { const float* p = sb + (size_t)(8 + 128 * b + cc) * 2048; h = p[0] * h + p[1]; }
        } else {
            if (is_lat) { for (int cc = 3; cc >= 0; --cc) { const float* p = sb + (size_t)(4 * b + cc) * 2048; h = p[0] * h + p[1]; }
                for (int cc = 127; cc > c; --cc) { const float* p = sb + (size_t)(8 + 128 * b + cc) * 2048; h = p[0] * h + p[1]; } }
            else for (int cc = 3; cc > c; --cc) { const float* p = sb + (size_t)(4 * b + cc) * 2048; h = p[0] * h + p[1]; }
        }
        if (dir == 0) {
#pragma unroll
            for (int q = 0; q < 4; ++q) { cin[(0 * 4 + q) * 128 + ch] = h; h = sub[((0 * 4 + q) * 128 + ch) * 2] * h + sub[((0 * 4 + q) * 128 + ch) * 2 + 1]; }
        } else {
#pragma unroll
            for (int q = 3; q >= 0; --q) { cin[(1 * 4 + q) * 128 + ch] = h; h = sub[((1 * 4 + q) * 128 + ch) * 2] * h + sub[((1 * 4 + q) * 128 + ch) * 2 + 1]; }
        }
    }
    __syncthreads();
    {
        float y[16]; float h = cin[(0 * 4 + tq) * 128 + ch];
#pragma unroll
        for (int t = 0; t < 16; ++t) { h = acc[0][t] * h + acc[1][t]; y[t] = h; }
        h = cin[(1 * 4 + tq) * 128 + ch];
#pragma unroll
        for (int t = 15; t >= 0; --t) { h = acc[2][t] * h + acc[3][t]; y[t] += h; }
#pragma unroll
        for (int t = 0; t < 16; ++t) { const size_t row = (size_t)(seq0 + t0 + tq * 16 + t); const float g = bf2f(F.P[row * 2048 + 1536 + cidx]);
            F.XN[row * D + 512 + cidx] = (bf16)f2bf(y[t] * gelu_tanh(g)); }
    }
    __syncthreads();
}

__device__ __forceinline__ LAS int* build_tiles(Frame& F, int layer) {
    LAS int* ts = (LAS int*)(F.lds + TS_OFF);
    if (F.tid == 0) { int a = 0;
        for (int e = 0; e < 16; ++e) { const int c = (int)__hip_atomic_load(F.ctl + CW_CNT + layer * 64 + e, RLX_AGENT); ts[e] = a; ts[17 + e] = c; a += (c + 255) >> 8; }
        ts[16] = a; }
    __syncthreads();
    return ts;
}

__device__ __forceinline__ void route_phase(Frame& F, int layer, int nrows) {
    LAS float* RwT = (LAS float*)F.lds;
    LAS int* lcnt = (LAS int*)(F.lds + 65536);
    LAS int* lbase = lcnt + 16;
    LAS int* tabi = lbase + 16;
    LAS float* tabw = (LAS float*)(tabi + 512);
    for (int i = F.tid; i < 16384; i += NWAVES * 64) RwT[(i & 15) * 1024 + (i >> 4)] = F.router_w[i];
    if (F.tid < 16) lcnt[F.tid] = 0;
    __syncthreads();
    const int per = (nrows + F.G - 1) / F.G, tok0 = blockIdx.x * per;
    float rb[16];
#pragma unroll
    for (int e = 0; e < 16; ++e) rb[e] = F.router_bias[e];
    for (int ti = F.wave; ti < per; ti += NWAVES) {
        const int token = tok0 + ti; if (token >= nrows) break;
        const int mi = (token >> 13) > 2 ? 2 : (token >> 13);
        f32x4 v[4], t[4];
#pragma unroll
        for (int j = 0; j < 4; ++j) v[j] = *(const f32x4*)(F.H + (size_t)token * D + 4 * F.lane + 256 * j);
        const float* md = F.mod + (layer * 3 + mi) * 6144;
        norm_mod_store(v, F.gffn + layer * D, md + 4096, md + 3072, F.XN + (size_t)token * D, F.lane, t);
        float score[16], sel[16];
#pragma unroll
        for (int e = 0; e < 16; ++e) { float p = 0.f;
#pragma unroll
            for (int j = 0; j < 4; ++j) { const f32x4 w = *(const LAS f32x4*)(RwT + e * 1024 + 4 * F.lane + 256 * j); p += (t[j].x * w.x + t[j].y * w.y) + (t[j].z * w.z + t[j].w * w.w); }
            p = wave_sum(p); score[e] = 1.f / (1.f + expf(-p)); sel[e] = score[e] + rb[e]; }
        int bg = 0; float bgs = -INFINITY;
#pragma unroll
        for (int g = 0; g < 4; ++g) { const float a = sel[4 * g], bq = sel[4 * g + 1], cq = sel[4 * g + 2], dq = sel[4 * g + 3];
            const float gs = fmaxf(fmaxf(fmaxf(a + bq, a + cq), fmaxf(a + dq, bq + cq)), fmaxf(bq + dq, cq + dq));
            if (gs > bgs) { bgs = gs; bg = g; } }
        float s4[4], c4[4];
#pragma unroll
        for (int j = 0; j < 4; ++j) { s4[j] = sel[j]; c4[j] = score[j]; }
#pragma unroll
        for (int g = 1; g < 4; ++g)
#pragma unroll
            for (int j = 0; j < 4; ++j) { s4[j] = (bg == g) ? sel[4 * g + j] : s4[j]; c4[j] = (bg == g) ? score[4 * g + j] : c4[j]; }
        int i1 = 0; float v1 = s4[0], sc1 = c4[0];
#pragma unroll
        for (int j = 1; j < 4; ++j) if (s4[j] > v1) { v1 = s4[j]; i1 = j; sc1 = c4[j]; }
        int i2 = -1; float v2 = -INFINITY, sc2 = 0.f;
#pragma unroll
        for (int j = 0; j < 4; ++j) if (j != i1 && s4[j] > v2) { v2 = s4[j]; i2 = j; sc2 = c4[j]; }
        if (F.lane == 0) { const int e0 = 4 * bg + i1, e1 = 4 * bg + i2; const float inv = 1.f / (sc1 + sc2);
            const int p0 = __hip_atomic_fetch_add(lcnt + e0, 1, __ATOMIC_RELAXED, __HIP_MEMORY_SCOPE_WORKGROUP), p1 = __hip_atomic_fetch_add(lcnt + e1, 1, __ATOMIC_RELAXED, __HIP_MEMORY_SCOPE_WORKGROUP);
            tabi[ti * 4 + 0] = e0; tabi[ti * 4 + 1] = p0; tabi[ti * 4 + 2] = e1; tabi[ti * 4 + 3] = p1; tabw[ti * 2] = sc1 * inv; tabw[ti * 2 + 1] = sc2 * inv; }
    }
    __syncthreads();
    if (F.tid < 16) lbase[F.tid] = (int)__hip_atomic_fetch_add(F.ctl + CW_CNT + layer * 64 + F.tid, (unsigned)lcnt[F.tid], RLX_AGENT);
    __syncthreads();
    if (F.tid < per && tok0 + F.tid < nrows) { const int token = tok0 + F.tid;
#pragma unroll
        for (int k = 0; k < 2; ++k) { const int e = tabi[F.tid * 4 + 2 * k], idx = lbase[e] + tabi[F.tid * 4 + 2 * k + 1];
            F.list[(size_t)layer * 16 * CAP + e * CAP + idx] = token; F.rslot[((size_t)layer * MALL + token) * 2 + k] = e * CAP + idx; F.rw[((size_t)layer * MALL + token) * 2 + k] = tabw[F.tid * 2 + k]; } }
    __syncthreads();
}

__device__ __forceinline__ void combine_phase(Frame& F, int layer, int nrows, bool final) {
    LAS int* ts = build_tiles(F, layer);
    const int gw = F.vcu * NWAVES + F.wave, NGW = F.G * NWAVES;
    for (int row = gw; row < nrows; row += NGW) {
        const int mi = (row >> 13) > 2 ? 2 : (row >> 13);
        const int s0 = F.rslot[((size_t)layer * MALL + row) * 2], s1 = F.rslot[((size_t)layer * MALL + row) * 2 + 1];
        const float w0 = F.rw[((size_t)layer * MALL + row) * 2], w1 = F.rw[((size_t)layer * MALL + row) * 2 + 1];
        const int e0 = s0 / CAP, e1 = s1 / CAP;
        const size_t y0 = (size_t)(ts[e0] * 256 + (s0 - e0 * CAP)), y1 = (size_t)(ts[e1] * 256 + (s1 - e1 * CAP));
        const float* md = F.mod + (layer * 3 + mi) * 6144;
        f32x4 v[4], t[4];
#pragma unroll
        for (int j = 0; j < 4; ++j) { const int col = 4 * F.lane + 256 * j;
            const v2u a = *(const v2u*)(F.Y + y0 * D + col), bq = *(const v2u*)(F.Y + y1 * D + col);
            f32x4 fa, fb; fa.x = __uint_as_float(a.x << 16); fa.y = __uint_as_float(a.x & 0xffff0000u); fa.z = __uint_as_float(a.y << 16); fa.w = __uint_as_float(a.y & 0xffff0000u);
            fb.x = __uint_as_float(bq.x << 16); fb.y = __uint_as_float(bq.x & 0xffff0000u); fb.z = __uint_as_float(bq.y << 16); fb.w = __uint_as_float(bq.y & 0xffff0000u);
            const f32x4 g2 = *(const f32x4*)(md + 5120 + col);
            v[j] = *(const f32x4*)(F.H + (size_t)row * D + col) + g2 * (fa * w0 + fb * w1); }
        if (!final) {
#pragma unroll
            for (int j = 0; j < 4; ++j) *(f32x4*)(F.H + (size_t)row * D + 4 * F.lane + 256 * j) = v[j];
            const float* md1 = F.mod + ((layer + 1) * 3 + mi) * 6144;
            norm_mod_store(v, F.gmix + (layer + 1) * D, md1 + 1024, md1, F.XN + (size_t)row * D, F.lane, t);
        } else {
            float s = 0.f;
#pragma unroll
            for (int j = 0; j < 4; ++j) s += (v[j].x * v[j].x + v[j].y * v[j].y) + (v[j].z * v[j].z + v[j].w * v[j].w);
            const float rstd = 1.f / sqrtf(wave_sum(s) * (1.f / D) + EPS);
#pragma unroll
            for (int j = 0; j < 4; ++j) { const int col = 4 * F.lane + 256 * j; *(f32x4*)(F.out + (size_t)row * D + col) = v[j] * rstd * *(const f32x4*)(F.final_g + col); }
        }
    }
}

__device__ __forceinline__ void unpack8(const v4u w, float (&f)[8]) {
    f[0] = __uint_as_float(w.x << 16); f[1] = __uint_as_float(w.x & 0xffff0000u); f[2] = __uint_as_float(w.y << 16); f[3] = __uint_as_float(w.y & 0xffff0000u);
    f[4] = __uint_as_float(w.z << 16); f[5] = __uint_as_float(w.z & 0xffff0000u); f[6] = __uint_as_float(w.w << 16); f[7] = __uint_as_float(w.w & 0xffff0000u);
}
__device__ __forceinline__ void natten_phase(Frame& F) {
    LAS float* rpbL = (LAS float*)F.lds;
    for (int i = F.tid; i < 8 * 15 * 31; i += NWAVES * 64) rpbL[i] = F.d_rpb[i];
    __syncthreads();
    const int gw = F.vcu * NWAVES + F.wave, NGW = F.G * NWAVES;
    const int hh = F.lane >> 3, dc = F.lane & 7, hoff = 64 * hh + 8 * dc;
    for (int qi = gw; qi < MLAT; qi += NGW) {
        const int b = qi >> 13, tt = qi & 8191, r = tt >> 6, c = tt & 63;
        const int rs = (r - 4) < 0 ? 0 : ((r - 4) > NROWS - 8 ? NROWS - 8 : (r - 4));
        const int cs = (c - 8) < 0 ? 0 : ((c - 8) > GRIDW - 16 ? GRIDW - 16 : (c - 8));
        float q[8], o[8]; unpack8(*(const v4u*)(F.P + (size_t)qi * 3072 + 1536 + hoff), q);
#pragma unroll
        for (int j = 0; j < 8; ++j) { q[j] *= 0.125f; o[j] = 0.f; }
        float m = -INFINITY, l = 0.f;
        for (int kr = 0; kr < 8; ++kr) {
            const LAS float* bias = rpbL + (hh * 15 + (rs + kr - r + 7)) * 31 + (cs - c + 15);
            const bf16* kb = F.P + ((size_t)b * SEQ + (rs + kr) * GRIDW + cs) * 3072 + 2048 + hoff;
#pragma unroll 4
            for (int j = 0; j < 16; ++j) {
                float kf[8], vf[8]; unpack8(*(const v4u*)(kb + (size_t)j * 3072), kf); unpack8(*(const v4u*)(kb + (size_t)j * 3072 + 512), vf);
                float s = 0.f;
#pragma unroll
                for (int d = 0; d < 8; ++d) s += q[d] * kf[d];
                s += __shfl_xor(s, 1); s += __shfl_xor(s, 2); s += __shfl_xor(s, 4);
                s += bias[j];
                const float mn = fmaxf(m, s), al = __expf(m - mn), p = __expf(s - mn);
                l = l * al + p; m = mn;
#pragma unroll
                for (int d = 0; d < 8; ++d) o[d] = o[d] * al + p * vf[d];
            }
        }
        {
            const bf16* kb = F.P + ((size_t)MLAT + b * CTXL) * 3072 + 2048 + hoff;
#pragma unroll 4
            for (int j = 0; j < CTXL; ++j) {
                float kf[8], vf[8]; unpack8(*(const v4u*)(kb + (size_t)j * 3072), kf); unpack8(*(const v4u*)(kb + (size_t)j * 3072 + 512), vf);
                float s = 0.f;
#pragma unroll
                for (int d = 0; d < 8; ++d) s += q[d] * kf[d];
                s += __shfl_xor(s, 1); s += __shfl_xor(s, 2); s += __shfl_xor(s, 4);
                const float mn = fmaxf(m, s), al = __expf(m - mn), p = __expf(s - mn);
                l = l * al + p; m = mn;
#pragma unroll
                for (int d = 0; d < 8; ++d) o[d] = o[d] * al + p * vf[d];
            }
        }
        const float il = 1.f / l;
        v4u w; w.x = pk2(o[0] * il, o[1] * il); w.y = pk2(o[2] * il, o[3] * il); w.z = pk2(o[4] * il, o[5] * il); w.w = pk2(o[6] * il, o[7] * il);
        *(v4u*)(F.XN + (size_t)qi * D + 512 + hoff) = w;
        {
            const int ch0 = 8 * F.lane; float accv[8];
#pragma unroll
            for (int d = 0; d < 8; ++d) accv[d] = 0.f;
#pragma unroll
            for (int k = 0; k < 3; ++k) { const int t2 = tt + k - 1;
                if (t2 >= 0 && t2 < SEQ) { float xi[8], cg[8]; const bf16* p = F.P + ((size_t)b * SEQ + t2) * 3072 + ch0; unpack8(*(const v4u*)p, xi); unpack8(*(const v4u*)(p + 1024), cg);
#pragma unroll
                    for (int d = 0; d < 8; ++d) accv[d] += F.c_conv_w[k * 512 + ch0 + d] * (cg[d] * xi[d]); } }
            float bgv[8]; unpack8(*(const v4u*)(F.P + (size_t)qi * 3072 + 512 + ch0), bgv);
            v4u w2; w2.x = pk2(bgv[0] * accv[0], bgv[1] * accv[1]); w2.y = pk2(bgv[2] * accv[2], bgv[3] * accv[3]); w2.z = pk2(bgv[4] * accv[4], bgv[5] * accv[5]); w2.w = pk2(bgv[6] * accv[6], bgv[7] * accv[7]);
            *(v4u*)(F.XN + (size_t)qi * D + ch0) = w2;
        }
    }
}

struct Args { const float* in[28]; float* out; unsigned char* ws; int ph_lo, ph_hi; };
__global__ void __launch_bounds__(NWAVES * 64, 2) hybrid_fwd(Args args) {
    extern __shared__ __attribute__((aligned(16))) unsigned char lds[];
    Frame F;
    F.lds = (LAS unsigned char*)lds;
    F.MISC = (volatile LAS unsigned*)(F.lds + MISC_OFF);
    F.tid = threadIdx.x; F.lane = F.tid & 63; F.wave = __builtin_amdgcn_readfirstlane(F.tid >> 6);
    F.G = gridDim.x; { const int bx = blockIdx.x; F.vcu = (F.G % 8 == 0) ? (bx % 8) * (F.G / 8) + bx / 8 : bx; }
    unsigned char* ws = args.ws;
    F.ctl = (gu32*)(ws + WS_CTL);
    F.x = args.in[0]; F.c = args.in[1]; F.ctx = args.in[2]; F.c_ctx = args.in[3]; F.ada_w = args.in[4]; F.ada_b = args.in[5]; F.gmix = args.in[6]; F.gffn = args.in[7];
    F.w_out = args.in[8]; F.ab_w_in = args.in[9]; F.a_dw_w = args.in[10]; F.a_dw_b = args.in[11]; F.a_ln_g = args.in[12]; F.a_ln_b = args.in[13]; F.b_conv_w = args.in[14]; F.b_conv_b = args.in[15];
    F.b_gate_w = args.in[16]; F.b_gate_b = args.in[17]; F.b_lambda = args.in[18]; F.cd_w_in = args.in[19]; F.c_conv_w = args.in[20]; F.d_rpb = args.in[21]; F.router_w = args.in[22]; F.router_bias = args.in[23];
    F.moe_wg = args.in[24]; F.moe_wu = args.in[25]; F.moe_wd = args.in[26]; F.final_g = args.in[27]; F.out = args.out;
    F.mod = (float*)(ws + WS_MOD); F.sum = (float*)(ws + WS_SUM); F.list = (int*)(ws + WS_LIST); F.rslot = (int*)(ws + WS_RSLOT); F.rw = (float*)(ws + WS_RW);
    F.Wab = (bf16*)(ws + WS_WAB); F.Wout = (bf16*)(ws + WS_WOUT); F.Wcd = (bf16*)(ws + WS_WCD); F.Wgu = (bf16*)(ws + WS_WGU); F.Wd = (bf16*)(ws + WS_WD);
    F.XN = (bf16*)(ws + WS_XN); F.P = (bf16*)(ws + WS_P); F.Y = (bf16*)(ws + WS_Y); F.HID = (bf16*)(ws + WS_HID); F.H = (float*)(ws + WS_H);
    for (int u = F.tid; u < (LDS_BYTES - LDSCTL_OFF) / 4; u += NWAVES * 64) ((LAS unsigned*)(F.lds + LDSCTL_OFF))[u] = 0u;
    __syncthreads();
    XcdBarrier bar; bar.bar = (unsigned*)(F.ctl + CW_BAR); bar.x = 0; bar.st = nullptr;
    const int lo = args.ph_lo, hi = args.ph_hi;
    const bool multi = (hi - lo) > 1;
    if (multi) bar = xcd_barrier_post((unsigned*)(F.ctl + CW_BAR), F.MISC + 8);
#define IN(k) (lo <= (k) && (k) < hi)
#define SEAM(k) do { if (IN(k) && IN((k) + 1)) xcd_barrier(bar); } while (0)
    const int bx = (int)blockIdx.x;

    if (IN(0)) { p0_prologue(F); } SEAM(0);
    if (IN(1)) { p1_norm0(F); } SEAM(1);
    if (IN(2)) {
        pg8::SchedPlain S; S.so.init(MALL / 256, 2048 / 256, F.G, bx); S.A = (const char*)F.XN; S.B = (const char*)F.Wab; S.tstep = (size_t)256 * 1024 * 2;
        pg8::EpiBf16 E{F.P, 2048};
        pg8::gemm_phase<pg8::EpiBf16, pg8::SchedPlain, true, true>(F.lds, 1024, S, E);
    } SEAM(2);
    if (IN(3)) {
        for (int u = F.vcu; u < MALL / 32; u += F.G) conf_unit(F, u);
        for (int u = F.vcu; u < 264 * 4; u += F.G) lru_unit(F, u, false);
    } SEAM(3);
    if (IN(4)) { for (int u = F.vcu; u < 264 * 4; u += F.G) lru_unit(F, u, true); } SEAM(4);
    if (IN(5)) {
        pg8::SchedPlain S; S.so.init(MALL / 256, 4, F.G, bx); S.A = (const char*)F.XN; S.B = (const char*)F.Wout; S.tstep = (size_t)256 * 1024 * 2;
        pg8::EpiRes E{F.x, F.H, F.H, F.mod + 0 * 3 * 6144 + 2048};
        pg8::gemm_phase<pg8::EpiRes, pg8::SchedPlain, true, true>(F.lds, 1024, S, E);
    } SEAM(5);
    if (IN(6)) { route_phase(F, 0, MALL); } SEAM(6);
    if (IN(7)) {
        LAS int* ts = build_tiles(F, 0);
        pg8::SchedMoeGU S; S.so.init(__builtin_amdgcn_readfirstlane(ts[16]), 4, F.G, bx); S.ts = ts; S.A = (const char*)F.XN; S.B = (const char*)F.Wgu; S.list = F.list;
        pg8::EpiGateUp E{F.HID};
        pg8::gemm_phase<pg8::EpiGateUp, pg8::SchedMoeGU, true, true>(F.lds, 1024, S, E);
    } SEAM(7);
    if (IN(8)) {
        LAS int* ts = build_tiles(F, 0);
        pg8::SchedMoeDown S; S.so.init(__builtin_amdgcn_readfirstlane(ts[16]), 4, F.G, bx); S.ts = ts; S.A = (const char*)F.HID; S.B = (const char*)F.Wd;
        pg8::EpiBf16 E{F.Y, 1024};
        pg8::gemm_phase<pg8::EpiBf16, pg8::SchedMoeDown, true, true>(F.lds, 512, S, E);
    } SEAM(8);
    if (IN(9)) { combine_phase(F, 0, MALL, false); } SEAM(9);
    if (IN(10)) {
        pg8::SchedPlain S; S.so.init(MALL / 256, 12, F.G, bx); S.A = (const char*)F.XN; S.B = (const char*)F.Wcd; S.tstep = (size_t)256 * 1024 * 2;
        pg8::EpiBf16 E{F.P, 3072};
        pg8::gemm_phase<pg8::EpiBf16, pg8::SchedPlain, true, true>(F.lds, 1024, S, E);
    } SEAM(10);
    if (IN(11)) { natten_phase(F); } SEAM(11);
    if (IN(12)) {
        pg8::SchedPlain S; S.so.init(MLAT / 256, 4, F.G, bx); S.A = (const char*)F.XN; S.B = (const char*)(F.Wout + (size_t)1024 * 1024); S.tstep = (size_t)256 * 1024 * 2;
        pg8::EpiRes E{F.H, F.H, F.H, F.mod + 1 * 3 * 6144 + 2048};
        pg8::gemm_phase<pg8::EpiRes, pg8::SchedPlain, true, true>(F.lds, 1024, S, E);
    } SEAM(12);
    if (IN(13)) { route_phase(F, 1, MLAT); } SEAM(13);
    if (IN(14)) {
        LAS int* ts = build_tiles(F, 1);
        pg8::SchedMoeGU S; S.so.init(__builtin_amdgcn_readfirstlane(ts[16]), 4, F.G, bx); S.ts = ts; S.A = (const char*)F.XN; S.B = (const char*)(F.Wgu + (size_t)16 * 1024 * 1024); S.list = F.list + (size_t)16 * CAP;
        pg8::EpiGateUp E{F.HID};
        pg8::gemm_phase<pg8::EpiGateUp, pg8::SchedMoeGU, true, true>(F.lds, 1024, S, E);
    } SEAM(14);
    if (IN(15)) {
        LAS int* ts = build_tiles(F, 1);
        pg8::SchedMoeDown S; S.so.init(__builtin_amdgcn_readfirstlane(ts[16]), 4, F.G, bx); S.ts = ts; S.A = (const char*)F.HID; S.B = (const char*)(F.Wd + (size_t)16 * 1024 * 512);
        pg8::EpiBf16 E{F.Y, 1024};
        pg8::gemm_phase<pg8::EpiBf16, pg8::SchedMoeDown, true, true>(F.lds, 512, S, E);
    } SEAM(15);
    if (IN(16)) { combine_phase(F, 1, MLAT, true); }
#undef IN
#undef SEAM
}

extern "C" void kernel_launch(void* const* d_in, const int* in_sizes, int n_in, void* d_out, int out_size, void* d_ws, size_t ws_size, hipStream_t stream) {
    static int grid = 0;
    if (grid == 0) {
        if (n_in != 28 || in_sizes[0] != MLAT * D || out_size != MLAT * D || ws_size < WS_END) {
            fprintf(stderr, "kernel_launch: unexpected shapes / workspace (n_in %d, in0 %d, out %d, ws %zu < %zu); nothing launched\n", n_in, n_in > 0 ? in_sizes[0] : -1, out_size, ws_size, (size_t)WS_END); grid = -1; return; }
        int dev = 0, cus = 0, per_cu = 0;
        if (hipGetDevice(&dev) != hipSuccess || hipDeviceGetAttribute(&cus, hipDeviceAttributeMultiprocessorCount, dev) != hipSuccess) { grid = -1; return; }
        if (hipFuncSetAttribute((const void*)hybrid_fwd, hipFuncAttributeMaxDynamicSharedMemorySize, LDS_BYTES) != hipSuccess) { fprintf(stderr, "kernel_launch: hipFuncSetAttribute failed\n"); grid = -1; return; }
        if (hipOccupancyMaxActiveBlocksPerMultiprocessor(&per_cu, (const void*)hybrid_fwd, NWAVES * 64, LDS_BYTES) != hipSuccess || per_cu < 1) { fprintf(stderr, "kernel_launch: occupancy query reports %d\n", per_cu); per_cu = 1; }
        (void)hipGetLastError();
        grid = cus;
        if (grid != 256) fprintf(stderr, "kernel_launch: %d CUs\n", grid);
    }
    if (grid < 0) return;
    if (hipMemsetAsync((char*)d_ws + WS_CTL, 0, CTL_ZERO_BYTES, stream) != hipSuccess) return;
    Args a{};
    for (int i = 0; i < 28; ++i) a.in[i] = (const float*)d_in[i];
    a.out = (float*)d_out; a.ws = (unsigned char*)d_ws;
    if (MK_N_LAUNCHES == 1) { a.ph_lo = 0; a.ph_hi = NPH; hipLaunchKernelGGL(hybrid_fwd, dim3(grid), dim3(NWAVES * 64), LDS_BYTES, stream, a); }
    else for (int p = 0; p < NPH; ++p) { a.ph_lo = p; a.ph_hi = p + 1; hipLaunchKernelGGL(hybrid_fwd, dim3(grid), dim3(NWAVES * 64), LDS_BYTES, stream, a); }
}
```

```cpp
#include <hip/hip_runtime.h>
#include <cstdio>
#include <cstdint>

#ifndef MK_N_LAUNCHES
#define MK_N_LAUNCHES 1
#endif

#define LAS __attribute__((address_space(3)))
#define GAS __attribute__((address_space(1)))
typedef unsigned short bf16;
typedef unsigned v4u __attribute__((ext_vector_type(4)));
typedef unsigned v2u __attribute__((ext_vector_type(2)));
typedef float f32x4 __attribute__((ext_vector_type(4)));
typedef float f32x2 __attribute__((ext_vector_type(2)));
typedef short bf16x8 __attribute__((ext_vector_type(8)));

constexpr int D = 1024, NBATCH = 2, SEQ = 8192, CTXL = 256;
constexpr int MLAT = NBATCH * SEQ;
constexpr int MCTX = NBATCH * CTXL;
constexpr int MALL = MLAT + MCTX;
constexpr int NEXP = 16, DFF = 512, CAP = MALL;
constexpr int GRIDW = 64, NROWS = SEQ / GRIDW;
constexpr float EPS = 1e-6f;
constexpr int NPH = 17;

constexpr size_t MiB = 1u << 20;
constexpr size_t WS_CTL = 0, CTL_ZERO_BYTES = 1 * MiB;
constexpr size_t WS_MOD = 1 * MiB;
constexpr size_t WS_SUM = 2 * MiB;
constexpr size_t WS_LIST = 5 * MiB;
constexpr size_t WS_RSLOT = 8 * MiB;
constexpr size_t WS_RW = 8 * MiB + 512 * 1024;
constexpr size_t WS_WAB = 10 * MiB;
constexpr size_t WS_WOUT = 14 * MiB;
constexpr size_t WS_WCD = 18 * MiB;
constexpr size_t WS_WGU = 24 * MiB;
constexpr size_t WS_WD = 88 * MiB;
constexpr size_t WS_XN = 120 * MiB;
constexpr size_t WS_H = 153 * MiB;
constexpr size_t WS_P = 219 * MiB;
constexpr int YROWS = 37632;
constexpr int P1LD = 2560;
constexpr size_t WS_VT = WS_P + (size_t)MALL * P1LD * 2;
constexpr float QSCALE = 0.125f * 1.4426950408889634f;
constexpr size_t WS_Y = WS_P, WS_HID = WS_P + (size_t)YROWS * 1024 * 2;
constexpr size_t WS_END = 330 * MiB;
static_assert(WS_HID + (size_t)YROWS * 512 * 2 <= WS_END, "ws map");
static_assert(WS_VT + (size_t)512 * MALL * 2 <= WS_END, "ws map");
constexpr int CW_BAR = 4096;
constexpr int CW_CNT = 16384;

constexpr int RING_BYTES = 131072;
constexpr int LDSCTL_OFF = RING_BYTES, MISC_OFF = LDSCTL_OFF + 320, TS_OFF = LDSCTL_OFF + 1024;
constexpr int LDS_BYTES = 147456;
constexpr int NWAVES = 8;

__device__ __forceinline__ float bf2f(bf16 b) { return __uint_as_float((unsigned)b << 16); }
__device__ __forceinline__ unsigned f2bf(float f) { unsigned u = __builtin_bit_cast(unsigned, f); return (u + 0x7fffu + ((u >> 16) & 1u)) >> 16; }
__device__ __forceinline__ unsigned pk2(float lo, float hi) { return f2bf(lo) | (f2bf(hi) << 16); }
__device__ __forceinline__ float sigm(float x) { return 1.f / (1.f + __expf(-x)); }
__device__ __forceinline__ float gelu_tanh(float x) { const float u = 0.7978845608028654f * (x + 0.044715f * x * x * x); return x * sigm(2.f * u); }
__device__ __forceinline__ float wave_sum(float v) {
#pragma unroll
    for (int o = 1; o < 64; o <<= 1) v += __shfl_xor(v, o);
    return v;
}
#define LDS_WAIT() asm volatile("s_waitcnt lgkmcnt(0)" ::: "memory")
#define RLX_AGENT __ATOMIC_RELAXED, __HIP_MEMORY_SCOPE_AGENT

namespace pg8 {
typedef unsigned short bf16_t;
typedef unsigned u32x4 __attribute__((ext_vector_type(4)));
constexpr int BM = 256, BK = 64, HALF = 128, HTB = HALF * BK * 2, STAGE_BYTES = 8 * HTB, NXCD = 8, WGM = 8;
__host__ __device__ __forceinline__ int lds_byte(int r, int c) { const int st = (r >> 4) * 2 + (c >> 5), rr = r & 15, cc = c & 31, ob = rr * 64 + cc * 2; return st * 1024 + (ob ^ (((ob >> 9) & 1) << 5)); }
__host__ __device__ __forceinline__ void stage_rc(int b, int& R, int& C) { const int st = b / 1024, sb = b % 1024, swz = sb ^ (((sb >> 9) & 1) << 5); R = (st >> 1) * 16 + swz / 64; C = (st & 1) * 32 + (swz % 64) / 2; }
__host__ __device__ __forceinline__ int perm32(int rho) { const int n = rho >> 4, i = rho & 15; return 8 * (i >> 2) + 4 * n + (i & 3); }

struct Unit { int pm, pn, e, r0, cnt; };

struct StaticOrder {
    int nM, nN, nwg, G, c;
    __device__ void init(int nM_, int nN_, int G_, int c_) { nM = nM_; nN = nN_; nwg = nM * nN; G = G_; c = c_; }
    __device__ bool next(int i, Unit& u) const {
        const long L = (long)i * G + c; if (L >= nwg) return false;
        int wgid = (int)L; { const int q = nwg / NXCD, r = nwg % NXCD, xcd = wgid % NXCD, off = wgid / NXCD; wgid = (xcd < r ? xcd * (q + 1) : r * (q + 1) + (xcd - r) * q) + off; }
        const int nig = WGM * nN, gid = wgid / nig, fm = gid * WGM, gsz = (nM - fm) < WGM ? (nM - fm) : WGM;
        u.pm = fm + ((wgid % nig) % gsz); u.pn = (wgid % nig) / gsz; u.e = 0; u.r0 = 0; u.cnt = 0; return true;
    }
};
struct SchedPlain {
    static constexpr bool GATHER = false;
    StaticOrder so; const char* A; const char* B; size_t tstep;
    __device__ __forceinline__ bool next(int i, Unit& u) const { return so.next(i, u); }
    __device__ __forceinline__ const char* a_ptr(const Unit& u) const { return A + (size_t)u.pm * tstep; }
    __device__ __forceinline__ const char* b_ptr(const Unit& u) const { return B + (size_t)u.pn * tstep; }
    __device__ __forceinline__ void a_offs(const Unit&, const int (&)[2], const int (&)[2], int, unsigned (&)[2][2]) const {}
};
struct SchedMoe {
    StaticOrder so; const LAS int* ts;
    __device__ __forceinline__ bool next(int i, Unit& u) const {
        if (!so.next(i, u)) return false;
        int e = 0;
#pragma unroll
        for (int j = 1; j < 16; ++j) e += (ts[j] <= u.pm) ? 1 : 0;
        e = __builtin_amdgcn_readfirstlane(e);
        u.e = e; u.r0 = (u.pm - __builtin_amdgcn_readfirstlane(ts[e])) * 256; u.cnt = __builtin_amdgcn_readfirstlane(ts[17 + e]); return true;
    }
};
struct SchedMoeGU : SchedMoe {
    static constexpr bool GATHER = true;
    const char* A; const char* B; const int* list;
    __device__ __forceinline__ const char* a_ptr(const Unit&) const { return A; }
    __device__ __forceinline__ const char* b_ptr(const Unit& u) const { return B + (size_t)u.e * (1024 * 1024 * 2) + (size_t)u.pn * (256 * 1024 * 2); }
    __device__ __forceinline__ void a_offs(const Unit& u, const int (&R)[2], const int (&C)[2], int K, unsigned (&v)[2][2]) const {
#pragma unroll
        for (int h = 0; h < 2; ++h)
#pragma unroll
            for (int i = 0; i < 2; ++i) { const int row = u.r0 + h * HALF + R[i]; int tok = 0; if (row < u.cnt) tok = list[u.e * CAP + row]; v[h][i] = (unsigned)(tok * K + C[i]) * 2u; }
    }
};
struct SchedMoeDown : SchedMoe {
    static constexpr bool GATHER = false;
    const char* A; const char* B;
    __device__ __forceinline__ const char* a_ptr(const Unit& u) const { return A + (size_t)u.pm * (256 * 512 * 2); }
    __device__ __forceinline__ const char* b_ptr(const Unit& u) const { return B + (size_t)u.e * (1024 * 512 * 2) + (size_t)u.pn * (256 * 512 * 2); }
    __device__ __forceinline__ void a_offs(const Unit&, const int (&)[2], const int (&)[2], int, unsigned (&)[2][2]) const {}
};

__device__ __forceinline__ unsigned cvt_pk_bf16(float lo, float hi) { unsigned r; asm volatile("v_cvt_pk_bf16_f32 %0, %1, %2" : "=v"(r) : "v"(lo), "v"(hi)); return r; }
struct EpiBf16 {
    static constexpr bool PERM = true;
    bf16_t* O; int ldc;
    __device__ __forceinline__ void operator()(const f32x4 (&acc)[2][2][4][2], const Unit& u, int wr, int wc, int fr, int fq) const {
        const int row0 = u.pm * BM + wr * 64 + fr, col0 = u.pn * BM + wc * 32 + 8 * fq;
#pragma unroll
        for (int ai = 0; ai < 2; ++ai)
#pragma unroll
            for (int m = 0; m < 4; ++m) { bf16_t* rowp = O + (size_t)(row0 + ai * HALF + m * 16) * ldc + col0;
#pragma unroll
                for (int bj = 0; bj < 2; ++bj) { const f32x4 v0 = acc[ai][bj][m][0], v1 = acc[ai][bj][m][1];
                    u32x4 w; w.x = cvt_pk_bf16(v0[0], v0[1]); w.y = cvt_pk_bf16(v0[2], v0[3]); w.z = cvt_pk_bf16(v1[0], v1[1]); w.w = cvt_pk_bf16(v1[2], v1[3]);
                    *(u32x4*)(rowp + bj * HALF) = w; } }
    }
};
struct EpiRes {
    static constexpr bool PERM = false;
    const float* hin_lat; const float* hin_ctx; float* hout; const float* gate;
    __device__ __forceinline__ void operator()(const f32x4 (&acc)[2][2][4][2], const Unit& u, int wr, int wc, int fr, int fq) const {
        const int row0 = u.pm * BM + wr * 64 + fr, col0 = u.pn * BM + wc * 32 + 4 * fq;
        const int mi = (u.pm >> 5) > 2 ? 2 : (u.pm >> 5);
        const float* src = (u.pm < 64) ? hin_lat : hin_ctx;
        f32x4 gv[2][2];
#pragma unroll
        for (int bj = 0; bj < 2; ++bj)
#pragma unroll
            for (int n = 0; n < 2; ++n) gv[bj][n] = *(const f32x4*)(gate + mi * 6144 + col0 + bj * HALF + n * 16);
#pragma unroll
        for (int ai = 0; ai < 2; ++ai)
#pragma unroll
            for (int m = 0; m < 4; ++m) { const size_t off = (size_t)(row0 + ai * HALF + m * 16) * D + col0;
#pragma unroll
                for (int bj = 0; bj < 2; ++bj)
#pragma unroll
                    for (int n = 0; n < 2; ++n) { const f32x4 b = *(const f32x4*)(src + off + bj * HALF + n * 16); *(f32x4*)(hout + off + bj * HALF + n * 16) = b + gv[bj][n] * acc[ai][bj][m][n]; } }
    }
};
struct EpiGateUp {
    static constexpr bool PERM = true;
    bf16_t* Hd;
    __device__ __forceinline__ void operator()(const f32x4 (&acc)[2][2][4][2], const Unit& u, int wr, int wc, int fr, int fq) const {
        const int row0 = u.pm * BM + wr * 64 + fr, col0 = u.pn * HALF + wc * 32 + 8 * fq;
#pragma unroll
        for (int ai = 0; ai < 2; ++ai)
#pragma unroll
            for (int m = 0; m < 4; ++m) { bf16_t* rowp = Hd + (size_t)(row0 + ai * HALF + m * 16) * DFF + col0;
                float h[8];
#pragma unroll
                for (int n = 0; n < 2; ++n)
#pragma unroll
                    for (int j = 0; j < 4; ++j) { const float g = acc[ai][0][m][n][j], up = acc[ai][1][m][n][j]; h[n * 4 + j] = g * sigm(g) * up; }
                u32x4 w; w.x = cvt_pk_bf16(h[0], h[1]); w.y = cvt_pk_bf16(h[2], h[3]); w.z = cvt_pk_bf16(h[4], h[5]); w.w = cvt_pk_bf16(h[6], h[7]);
                *(u32x4*)rowp = w; }
    }
};

struct SchedInproj1 {
    static constexpr bool GATHER = false;
    StaticOrder so; const char* X; const char* W; int G, c;
    __device__ __forceinline__ bool next(int i, Unit& u) const {
        const int L = i * G + c;
        if (L < 640) { return so.next(i, u); }
        if (L < 768) { const int idx = L - 640; u.pm = idx & 1; u.pn = idx >> 1; u.e = 1; u.r0 = 0; u.cnt = 0; return true; }
        if (L < 776) { const int idx = L - 768; if (idx < 4) { u.pm = 64 + (idx >> 1); u.pn = 8 + (idx & 1); u.e = 0; } else { u.pm = idx & 1; u.pn = 64 + ((idx >> 1) & 1); u.e = 1; } u.r0 = 0; u.cnt = 0; return true; }
        return false;
    }
    __device__ __forceinline__ const char* a_ptr(const Unit& u) const { return u.e ? W + (size_t)(10 + u.pm) * (256 * 1024 * 2) : X + (size_t)u.pm * (256 * 1024 * 2); }
    __device__ __forceinline__ const char* b_ptr(const Unit& u) const { return u.e ? X + (size_t)u.pn * (256 * 1024 * 2) : W + (size_t)u.pn * (256 * 1024 * 2); }
    __device__ __forceinline__ void a_offs(const Unit&, const int (&)[2], const int (&)[2], int, unsigned (&)[2][2]) const {}
};
struct EpiInproj1 {
    static constexpr bool PERM = true;
    bf16_t* P; bf16_t* VT;
    __device__ __forceinline__ void operator()(const f32x4 (&acc)[2][2][4][2], const Unit& u, int wr, int wc, int fr, int fq) const {
        const int row0 = u.pm * BM + wr * 64 + fr, col0 = u.pn * BM + wc * 32 + 8 * fq;
        bf16_t* O = u.e ? VT : P; const int ldc = u.e ? MALL : P1LD;
        const float sc = (!u.e && (u.pn == 6 || u.pn == 7)) ? QSCALE : 1.0f;
#pragma unroll
        for (int ai = 0; ai < 2; ++ai)
#pragma unroll
            for (int m = 0; m < 4; ++m) { bf16_t* rowp = O + (size_t)(row0 + ai * HALF + m * 16) * ldc + col0;
#pragma unroll
                for (int bj = 0; bj < 2; ++bj) { const f32x4 v0 = acc[ai][bj][m][0] * sc, v1 = acc[ai][bj][m][1] * sc;
                    u32x4 w; w.x = cvt_pk_bf16(v0[0], v0[1]); w.y = cvt_pk_bf16(v0[2], v0[3]); w.z = cvt_pk_bf16(v1[0], v1[1]); w.w = cvt_pk_bf16(v1[2], v1[3]);
                    *(u32x4*)(rowp + bj * HALF) = w; } }
    }
};

template <class Epi, class Sched, bool ALIGN_EPI, bool SP2>
__device__ __forceinline__ void gemm_phase(LAS unsigned char* lds, const int K, const Sched& S, const Epi& E) {
    const int tid = threadIdx.x, wid = __builtin_amdgcn_readfirstlane(tid >> 6), lane = tid & 63, wr = wid >> 2, wc = wid & 3, fr = lane & 15, fq = lane >> 4;
    const int nt = K / BK;
    const size_t kstep = (size_t)(BK * 2);
    const size_t hstep = (size_t)HALF * K * 2;
    int Rr[2], Cc[2]; unsigned voffB[2], vA[2][2], nvA[2][2];
#pragma unroll
    for (int i = 0; i < 2; ++i) { int R, C; stage_rc(tid * 16 + i * 8192, R, C); Rr[i] = R; Cc[i] = C; const int Rb = Epi::PERM ? ((R & ~31) + perm32(R & 31)) : R;
        voffB[i] = (unsigned)(Rb * K + C) * 2u; vA[0][i] = (unsigned)(R * K + C) * 2u; vA[1][i] = vA[0][i] + (unsigned)hstep; nvA[0][i] = vA[0][i]; nvA[1][i] = vA[1][i]; }
    const unsigned ldsw = (unsigned)wid * 1024u;
    const int aoff = lds_byte(wr * 64 + fr, fq * 8), boff = lds_byte(wc * 32 + fr, fq * 8);
#define PG8_SA(b, h) (((b) * 2 + (h)) * HTB)
#define PG8_SB(b, h) ((4 + (b) * 2 + (h)) * HTB)
#define PG8_STAGE(bufoff, gbase, voff) do { _Pragma("unroll") for (int _i = 0; _i < 2; ++_i) \
        __builtin_amdgcn_global_load_lds((const unsigned*)((const char*)(gbase) + (voff)[_i]), (LAS unsigned*)(lds + (bufoff) + ldsw + _i * 8192), 16, 0, 0); } while (0)
#define PG8_LDA(dst, b, h) do { _Pragma("unroll") for (int m = 0; m < 4; ++m) _Pragma("unroll") for (int k = 0; k < 2; ++k) dst[m][k] = *(const LAS bf16x8*)(lds + PG8_SA(b, h) + aoff + m * 2048 + k * 1024); } while (0)
#define PG8_LDB(dst, b, h) do { _Pragma("unroll") for (int n = 0; n < 2; ++n) _Pragma("unroll") for (int k = 0; k < 2; ++k) dst[n][k] = *(const LAS bf16x8*)(lds + PG8_SB(b, h) + boff + n * 2048 + k * 1024); } while (0)
#define PG8_MMA(ai, bj, At, Bt) do { __builtin_amdgcn_s_setprio(1); _Pragma("unroll") for (int m = 0; m < 4; ++m) _Pragma("unroll") for (int n = 0; n < 2; ++n) _Pragma("unroll") for (int k = 0; k < 2; ++k) \
        acc[ai][bj][m][n] = __builtin_amdgcn_mfma_f32_16x16x32_bf16(Bt[n][k], At[m][k], acc[ai][bj][m][n], 0, 0, 0); __builtin_amdgcn_s_setprio(0); } while (0)
#define PG8_WAIT_V(n) asm volatile("s_waitcnt vmcnt(" #n ")" ::: "memory")
#define PG8_WAIT_L(n) asm volatile("s_waitcnt lgkmcnt(" #n ")" ::: "memory")
#define PG8_BAR __builtin_amdgcn_s_barrier()
#define PG8_SCHED __builtin_amdgcn_sched_barrier(0)
    Unit cur, nxt; int ui = 0;
    if (!S.next(0, cur)) return;
    if constexpr (Sched::GATHER) { S.a_offs(cur, Rr, Cc, K, vA); }
    f32x4 acc[2][2][4][2];
#pragma unroll
    for (int a = 0; a < 2; ++a)
#pragma unroll
        for (int b = 0; b < 2; ++b)
#pragma unroll
            for (int m = 0; m < 4; ++m)
#pragma unroll
                for (int n = 0; n < 2; ++n) acc[a][b][m][n] = (f32x4){0.f, 0.f, 0.f, 0.f};
    bf16x8 At[4][2], B0[2][2], B1[2][2];
    const char* cA = S.a_ptr(cur); const char* cB = S.b_ptr(cur);
    static_assert(SP2, "only the two-super-phase loop is kept");
    PG8_STAGE(PG8_SB(0, 0), cB, voffB); PG8_STAGE(PG8_SB(0, 1), cB + hstep, voffB); PG8_STAGE(PG8_SA(0, 0), cA, vA[0]); PG8_STAGE(PG8_SA(0, 1), cA, vA[1]);
    if (wr == 1) PG8_BAR;
    PG8_WAIT_V(2); PG8_BAR;
    PG8_STAGE(PG8_SB(1, 0), cB + kstep, voffB); PG8_STAGE(PG8_SA(1, 0), cA + kstep, vA[0]); PG8_STAGE(PG8_SB(1, 1), cB + hstep + kstep, voffB);
    PG8_WAIT_V(6); PG8_BAR;
    for (;;) {
        const bool has_next = S.next(ui + 1, nxt);
        const char* nA = has_next ? S.a_ptr(nxt) : cA; const char* nB = has_next ? S.b_ptr(nxt) : cB;
        if constexpr (Sched::GATHER) { if (has_next) S.a_offs(nxt, Rr, Cc, K, nvA); }
        for (int t = 0; t < nt; t += 2) {
            const bool last = (t == nt - 2);
            const char* a1 = cA + (size_t)(t + 1) * kstep;
            const char* a2 = last ? nA : cA + (size_t)(t + 2) * kstep; const char* b2 = last ? nB : cB + (size_t)(t + 2) * kstep;
            const char* a3 = a2 + kstep; const char* b3 = b2 + kstep;
            unsigned wA[2][2];
#pragma unroll
            for (int h = 0; h < 2; ++h)
#pragma unroll
                for (int i = 0; i < 2; ++i) wA[h][i] = (Sched::GATHER && last) ? nvA[h][i] : vA[h][i];
            PG8_LDB(B0, 0, 0); PG8_LDB(B1, 0, 1); PG8_SCHED; PG8_LDA(At, 0, 0); PG8_STAGE(PG8_SA(1, 1), a1, vA[1]);
            PG8_WAIT_V(8); PG8_WAIT_L(0); PG8_BAR; PG8_MMA(0, 0, At, B0); PG8_MMA(0, 1, At, B1); PG8_BAR; PG8_SCHED;
            PG8_LDA(At, 0, 1); PG8_STAGE(PG8_SB(0, 0), b2, voffB); PG8_STAGE(PG8_SB(0, 1), b2 + hstep, voffB); PG8_STAGE(PG8_SA(0, 0), a2, wA[0]);
            PG8_WAIT_V(8); PG8_WAIT_L(0); PG8_BAR; PG8_MMA(1, 0, At, B0); PG8_MMA(1, 1, At, B1); PG8_BAR; PG8_SCHED;
            PG8_LDB(B0, 1, 0); PG8_LDB(B1, 1, 1); PG8_SCHED; PG8_LDA(At, 1, 0); PG8_STAGE(PG8_SA(0, 1), a2, wA[1]);
            PG8_WAIT_V(8); PG8_WAIT_L(0); PG8_BAR; PG8_MMA(0, 0, At, B0); PG8_MMA(0, 1, At, B1); PG8_BAR; PG8_SCHED;
            PG8_LDA(At, 1, 1); PG8_STAGE(PG8_SB(1, 0), b3, voffB); PG8_STAGE(PG8_SB(1, 1), b3 + hstep, voffB); PG8_STAGE(PG8_SA(1, 0), a3, wA[0]);
            PG8_WAIT_V(8); PG8_WAIT_L(0); PG8_BAR; PG8_MMA(1, 0, At, B0); PG8_MMA(1, 1, At, B1); PG8_BAR; PG8_SCHED;
        }
        if constexpr (ALIGN_EPI) { if (wr == 0) PG8_BAR; }
        E(acc, cur, wr, wc, fr, fq);
        if (!has_next) break;
#pragma unroll
        for (int a = 0; a < 2; ++a)
#pragma unroll
            for (int b = 0; b < 2; ++b)
#pragma unroll
                for (int m = 0; m < 4; ++m)
#pragma unroll
                    for (int n = 0; n < 2; ++n) acc[a][b][m][n] = (f32x4){0.f, 0.f, 0.f, 0.f};
        cur = nxt; cA = nA; cB = nB; ++ui;
        if constexpr (Sched::GATHER) {
#pragma unroll
            for (int h = 0; h < 2; ++h)
#pragma unroll
                for (int i = 0; i < 2; ++i) vA[h][i] = nvA[h][i];
        }
        if constexpr (ALIGN_EPI) { if (wr == 1) PG8_BAR; }
    }
    PG8_WAIT_V(0);
    if constexpr (!ALIGN_EPI) { if (wr == 0) PG8_BAR; }
    PG8_BAR;
#undef PG8_SA
#undef PG8_SB
#undef PG8_STAGE
#undef PG8_LDA
#undef PG8_LDB
#undef PG8_MMA
#undef PG8_WAIT_V
#undef PG8_WAIT_L
#undef PG8_BAR
#undef PG8_SCHED
}
}

typedef GAS unsigned gu32;
#define XB_TMO      128
#define XB_XCNT(j)  (256  + 64 * (j))
#define XB_XSUB(j)  (1280 + 64 * (j))
#define XB_XGEN(j)  (2304 + 64 * (j))
#define XB_TOP      3328
#define XB_TOPGEN   3392
#define XCD_BAR_WORDS 3456
#define XB_SPIN_CAP (1u << 20)
__device__ __forceinline__ unsigned xb_ld(unsigned* p)              { return __hip_atomic_load(p, __ATOMIC_RELAXED, __HIP_MEMORY_SCOPE_AGENT); }
__device__ __forceinline__ unsigned xb_add(unsigned* p, unsigned v) { return __hip_atomic_fetch_add(p, v, __ATOMIC_RELAXED, __HIP_MEMORY_SCOPE_AGENT); }
__device__ __forceinline__ unsigned xb_xcc_id() { return (unsigned)__builtin_amdgcn_s_getreg((3 << 11) | 20) & 0xFu; }
#define XB_SPIN(cond, bar) do { unsigned _sp = 0; while (cond) { __builtin_amdgcn_s_sleep(1); \
    if ((++_sp & 255u) == 0u) { if (xb_ld(&(bar)[XB_TMO])) break; if (_sp > XB_SPIN_CAP) { atomicAdd(&(bar)[XB_TMO], 1u); break; } } } } while (0)
struct XcdBarrier { unsigned* bar; unsigned x; volatile LAS unsigned* st; };
__device__ __forceinline__ XcdBarrier xcd_barrier_post(unsigned* bar, volatile LAS unsigned* st) {
    XcdBarrier b; b.bar = bar; b.x = xb_xcc_id(); b.st = st;
    if (threadIdx.x == 0) (void)xb_add(&bar[XB_XCNT(b.x)], 1u);
    return b;
}
__device__ __forceinline__ void xcd_barrier_complete(unsigned* bar, unsigned x, unsigned& nloc, unsigned& nx) {
    const unsigned G = gridDim.x * gridDim.y * gridDim.z;
    unsigned sum, cnt, mine, sp = 0u;
    for (;;) {
        sum = 0u; cnt = 0u; mine = 0u;
#pragma unroll
        for (unsigned j = 0; j < 16; ++j) { const unsigned c = xb_ld(&bar[XB_XCNT(j)]); sum += c; cnt += (c > 0u) ? 1u : 0u; mine = (j == x) ? c : mine; }
        if (sum == G) break;
        __builtin_amdgcn_s_sleep(1);
        if ((++sp & 255u) == 0u) { if (xb_ld(&bar[XB_TMO])) break; if (sp > XB_SPIN_CAP) { atomicAdd(&bar[XB_TMO], 1u); break; } }
    }
    nloc = mine > 0u ? mine : 1u; nx = cnt > 0u ? cnt : 1u;
}
__device__ __forceinline__ void xcd_barrier(const XcdBarrier& b) {
    asm volatile("s_waitcnt vmcnt(0)" ::: "memory");
    __syncthreads();
    if (threadIdx.x == 0) {
        unsigned* bar = b.bar;
        __builtin_amdgcn_s_waitcnt(0);
        unsigned nloc = b.st[0], nx = b.st[1];
        if (nloc == 0u) { xcd_barrier_complete(bar, b.x, nloc, nx); b.st[0] = nloc; b.st[1] = nx; }
        const unsigned old = xb_add(&bar[XB_XSUB(b.x)], 1u);
        const unsigned gen = old / nloc;
        if (old + 1u == (gen + 1u) * nloc) {
            __builtin_amdgcn_fence(__ATOMIC_RELEASE, "agent");
            asm volatile("s_waitcnt vmcnt(0)" ::: "memory");
            const unsigned og = xb_add(&bar[XB_TOP], 1u);
            const unsigned tg = og / nx;
            if (og + 1u == (tg + 1u) * nx) xb_add(&bar[XB_TOPGEN], 1u);
            else XB_SPIN(xb_ld(&bar[XB_TOPGEN]) == tg, bar);
            __builtin_amdgcn_fence(__ATOMIC_ACQUIRE, "agent");
            xb_add(&bar[XB_XGEN(b.x)], 1u);
            asm volatile("s_waitcnt vmcnt(0)" ::: "memory");
        } else {
            XB_SPIN(xb_ld(&bar[XB_XGEN(b.x)]) == gen, bar);
            __builtin_amdgcn_fence(__ATOMIC_ACQUIRE, "agent");
            asm volatile("s_waitcnt vmcnt(0)" ::: "memory");
        }
    }
    __syncthreads();
}

struct Frame {
    LAS unsigned char* lds;
    volatile LAS unsigned* MISC;
    gu32* ctl;
    int tid, lane, wave, vcu, G;
    const float *x, *c, *ctx, *c_ctx, *ada_w, *ada_b, *gmix, *gffn, *w_out, *ab_w_in, *a_dw_w, *a_dw_b, *a_ln_g, *a_ln_b, *b_conv_w, *b_conv_b, *b_gate_w, *b_gate_b, *b_lambda,
        *cd_w_in, *c_conv_w, *d_rpb, *router_w, *router_bias, *moe_wg, *moe_wu, *moe_wd, *final_g;
    float* out;
    float* mod; float* sum; int* list; int* rslot; float* rw;
    bf16 *Wab, *Wout, *Wcd, *Wgu, *Wd;
    bf16 *XN, *P, *Y, *HID, *VT; float* H;
};

__device__ __forceinline__ void p0_transpose_item(const float* W, int K, int N, bf16* WT, int rbase, int rstride, LAS float* scr, int item, int lane) {
    const int nblk = N / 32, kb = item / nblk, nb = item % nblk, k0 = 64 * kb, n0 = 32 * nb;
    const int orow0 = rbase + (n0 >> 7) * rstride + (n0 & 127);
#pragma unroll 8
    for (int i = 0; i < 32; ++i) { const int kk = 2 * i + (lane >> 5); scr[kk * 33 + (lane & 31)] = W[(size_t)(k0 + kk) * N + n0 + (lane & 31)]; }
    LDS_WAIT(); asm volatile("" ::: "memory");
    const int c = lane & 7;
#pragma unroll
    for (int j = 0; j < 4; ++j) { const int n = (lane >> 3) + 8 * j; const LAS float* s = scr + (8 * c) * 33 + n;
        v4u o; o.x = pk2(s[0 * 33], s[1 * 33]); o.y = pk2(s[2 * 33], s[3 * 33]); o.z = pk2(s[4 * 33], s[5 * 33]); o.w = pk2(s[6 * 33], s[7 * 33]);
        *(GAS v4u*)(WT + (size_t)(orow0 + n) * K + k0 + 8 * c) = o; }
    LDS_WAIT(); asm volatile("" ::: "memory");
}

__device__ __forceinline__ void p0_prologue(Frame& F) {
    LAS float* condL = (LAS float*)F.lds;
    LAS float* red = condL + 3 * 1024;
    for (int i = F.tid; i < 3072; i += NWAVES * 64) { const int m = i >> 10, k = i & 1023; const float cv = (m < 2) ? F.c[m * 1024 + k] : F.c_ctx[k]; condL[i] = cv * sigm(cv); }
    __syncthreads();
    if (blockIdx.x < 192) {
        const int cg = blockIdx.x, layer = cg / 96, col0 = (cg % 96) * 64;
        const float* W = F.ada_w + (size_t)layer * 1024 * 6144 + col0 + F.lane;
        const int k0 = F.wave * 128;
        float a0 = 0.f, a1 = 0.f, a2 = 0.f;
#pragma unroll 8
        for (int kk = 0; kk < 128; ++kk) { const int k = k0 + kk; const float w = W[(size_t)k * 6144]; a0 += condL[k] * w; a1 += condL[1024 + k] * w; a2 += condL[2048 + k] * w; }
        red[(F.wave * 3 + 0) * 64 + F.lane] = a0; red[(F.wave * 3 + 1) * 64 + F.lane] = a1; red[(F.wave * 3 + 2) * 64 + F.lane] = a2;
        __syncthreads();
        if (F.tid < 192) { const int m = F.tid >> 6, l = F.tid & 63; float s = 0.f;
#pragma unroll
            for (int w = 0; w < 8; ++w) s += red[(w * 3 + m) * 64 + l];
            F.mod[(layer * 3 + m) * 6144 + col0 + l] = s + F.ada_b[layer * 6144 + col0 + l]; }
    }
    __syncthreads();
    LAS float* scr = (LAS float*)(F.lds + F.wave * 16384);
    const int gw = F.vcu * NWAVES + F.wave, NGW = F.G * NWAVES;
    constexpr int I_AB = 16 * 64, I_OUT = 16 * 32, I_CD = 16 * 96, I_G = 16 * 16, I_DN = 8 * 32;
    constexpr int NITEMS = I_AB + 2 * I_OUT + I_CD + 32 * (2 * I_G + I_DN);
    for (int it = gw; it < NITEMS; it += NGW) {
        int r = it;
        if (r < I_AB) { p0_transpose_item(F.ab_w_in, 1024, 2048, F.Wab, 0, 128, scr, r, F.lane); continue; } r -= I_AB;
        if (r < 2 * I_OUT) { const int l = r / I_OUT; p0_transpose_item(F.w_out + (size_t)l * 1024 * 1024, 1024, 1024, F.Wout + (size_t)l * 1024 * 1024, 0, 128, scr, r % I_OUT, F.lane); continue; } r -= 2 * I_OUT;
        if (r < I_CD) { p0_transpose_item(F.cd_w_in, 1024, 3072, F.Wcd, 0, 128, scr, r, F.lane); continue; } r -= I_CD;
        if (r < 32 * I_G) { const int le = r / I_G; p0_transpose_item(F.moe_wg + (size_t)le * 1024 * 512, 1024, 512, F.Wgu + (size_t)le * 1024 * 1024, 0, 256, scr, r % I_G, F.lane); continue; } r -= 32 * I_G;
        if (r < 32 * I_G) { const int le = r / I_G; p0_transpose_item(F.moe_wu + (size_t)le * 1024 * 512, 1024, 512, F.Wgu + (size_t)le * 1024 * 1024, 128, 256, scr, r % I_G, F.lane); continue; } r -= 32 * I_G;
        { const int le = r / I_DN; p0_transpose_item(F.moe_wd + (size_t)le * 512 * 1024, 512, 1024, F.Wd + (size_t)le * 1024 * 512, 0, 128, scr, r % I_DN, F.lane); }
    }
}

__device__ __forceinline__ void norm_mod_store(const f32x4 (&v)[4], const float* g, const float* sc, const float* sh, bf16* dst, int lane, f32x4 (&t)[4]) {
    float s = 0.f;
#pragma unroll
    for (int j = 0; j < 4; ++j) s += (v[j].x * v[j].x + v[j].y * v[j].y) + (v[j].z * v[j].z + v[j].w * v[j].w);
    const float rstd = 1.f / sqrtf(wave_sum(s) * (1.f / D) + EPS);
#pragma unroll
    for (int j = 0; j < 4; ++j) { const int col = 4 * lane + 256 * j;
        const f32x4 gg = *(const f32x4*)(g + col), ss = *(const f32x4*)(sc + col), hh = *(const f32x4*)(sh + col);
        t[j] = v[j] * rstd * gg * (ss + 1.0f) + hh;
        v2u o; o.x = pk2(t[j].x, t[j].y); o.y = pk2(t[j].z, t[j].w);
        *(v2u*)(dst + col) = o; }
}

__device__ __forceinline__ void p1_norm0(Frame& F) {
    const int gw = F.vcu * NWAVES + F.wave, NGW = F.G * NWAVES;
    for (int row = gw; row < MALL; row += NGW) {
        const float* src = (row < MLAT) ? F.x + (size_t)row * D : F.ctx + (size_t)(row - MLAT) * D;
        const int mi = (row >> 13) > 2 ? 2 : (row >> 13);
        f32x4 v[4], t[4];
#pragma unroll
        for (int j = 0; j < 4; ++j) v[j] = *(const f32x4*)(src + 4 * F.lane + 256 * j);
        const float* md = F.mod + (0 * 3 + mi) * 6144;
        norm_mod_store(v, F.gmix, md + 1024, md, F.XN + (size_t)row * D, F.lane, t);
        if (row >= MLAT) {
#pragma unroll
            for (int j = 0; j < 4; ++j) *(f32x4*)(F.H + (size_t)row * D + 4 * F.lane + 256 * j) = v[j];
        }
    }
}

__device__ __forceinline__ void conf_unit(Frame& F, int u) {
    const int row0 = u * 32; int seq0, L;
    if (row0 < MLAT) { seq0 = (row0 >> 13) << 13; L = SEQ; } else { seq0 = MLAT + (((row0 - MLAT) >> 8) << 8); L = CTXL; }
    const int t0 = row0 - seq0, ch = F.tid;
    float uu[62];
#pragma unroll
    for (int tt = 0; tt < 62; ++tt) { const int t = t0 - 15 + tt; float val = 0.f;
        if (t >= 0 && t < L) { const bf16* p = F.P + (size_t)(seq0 + t) * 2048 + ch; const float v = bf2f(p[0]), g = bf2f(p[512]); val = v * sigm(g); }
        uu[tt] = val; }
    float o[32]; const float bias = F.a_dw_b[ch];
#pragma unroll
    for (int t = 0; t < 32; ++t) o[t] = bias;
#pragma unroll
    for (int k = 0; k < 31; ++k) { const float w = F.a_dw_w[k * 512 + ch];
#pragma unroll
        for (int t = 0; t < 32; ++t) o[t] += w * uu[t + k]; }
    LAS float* red = (LAS float*)F.lds;
    LAS float* fin = red + 512;
    float mine = 0.f;
#pragma unroll
    for (int t = 0; t < 32; ++t) { const float s = wave_sum(o[t]), q = wave_sum(o[t] * o[t]); mine = (F.lane == t) ? s : mine; mine = (F.lane == 32 + t) ? q : mine; }
    red[F.wave * 64 + F.lane] = mine;
    __syncthreads();
    if (F.tid < 64) { float s = 0.f;
#pragma unroll
        for (int w = 0; w < 8; ++w) s += red[w * 64 + F.tid];
        fin[F.tid] = s; }
    __syncthreads();
    const float lg = F.a_ln_g[ch], lb = F.a_ln_b[ch];
#pragma unroll
    for (int t = 0; t < 32; ++t) { const float mean = fin[t] * (1.f / 512.f); float var = fin[32 + t] * (1.f / 512.f) - mean * mean; var = var < 0.f ? 0.f : var;
        const float y = (o[t] - mean) * (1.f / sqrtf(var + EPS)) * lg + lb;
        F.XN[(size_t)(row0 + t) * D + ch] = (bf16)f2bf(y * sigm(y)); }
    __syncthreads();
}

__device__ __forceinline__ void lru_unit(Frame& F, int u, bool final) {
    const int n = u & 3, sc = u >> 2;
    int b, c, seq0, L; bool is_lat;
    if (sc < 8) { is_lat = false; b = sc >> 2; c = sc & 3; seq0 = MLAT + b * CTXL; L = CTXL; } else { is_lat = true; b = (sc - 8) >> 7; c = (sc - 8) & 127; seq0 = b * SEQ; L = SEQ; }
    const int t0 = c * 64, ch = F.tid & 127, tq = F.tid >> 7, cidx = 128 * n + ch;
    LAS float* vs = (LAS float*)F.lds;
    LAS float* sub = vs + 64 * 128;
    LAS float* cin = sub + 2048;
    float vown[16];
    {
        float uu[19];
#pragma unroll
        for (int tt = 0; tt < 19; ++tt) { const int t = t0 + tq * 16 + tt - 2; uu[tt] = (t >= 0 && t < L) ? bf2f(F.P[(size_t)(seq0 + t) * 2048 + 1024 + cidx]) : 0.f; }
        const float w0 = F.b_conv_w[cidx], w1 = F.b_conv_w[512 + cidx], w2 = F.b_conv_w[1024 + cidx], w3 = F.b_conv_w[1536 + cidx], cb = F.b_conv_b[cidx];
#pragma unroll
        for (int t = 0; t < 16; ++t) { vown[t] = cb + w0 * uu[t] + w1 * uu[t + 1] + w2 * uu[t + 2] + w3 * uu[t + 3]; vs[(tq * 16 + t) * 128 + ch] = vown[t]; }
    }
    __syncthreads();
    float acc[4][16];
#pragma unroll
    for (int m = 0; m < 4; ++m)
#pragma unroll
        for (int t = 0; t < 16; ++t) acc[m][t] = 0.f;
    const float* Wg = F.b_gate_w + (size_t)n * 16384 + ch;
    for (int k4 = 0; k4 < 128; k4 += 4) {
        float w[4][4];
#pragma unroll
        for (int m = 0; m < 4; ++m)
#pragma unroll
            for (int kk = 0; kk < 4; ++kk) w[m][kk] = Wg[(size_t)m * 65536 + (k4 + kk) * 128];
#pragma unroll
        for (int t = 0; t < 16; ++t) { const f32x4 vv = *(const LAS f32x4*)(vs + (tq * 16 + t) * 128 + k4);
#pragma unroll
            for (int m = 0; m < 4; ++m) acc[m][t] += (vv.x * w[m][0] + vv.y * w[m][1]) + (vv.z * w[m][2] + vv.w * w[m][3]); }
    }
#pragma unroll
    for (int d = 0; d < 2; ++d) {
        const float lam = F.b_lambda[d * 512 + cidx]; const float spd = log1pf(__expf(-lam));
        const float br = F.b_gate_b[(d * 2 + 0) * 512 + cidx], bi = F.b_gate_b[(d * 2 + 1) * 512 + cidx];
#pragma unroll
        for (int t = 0; t < 16; ++t) { const float r = sigm(acc[2 * d][t] + br), ii = sigm(acc[2 * d + 1][t] + bi);
            const float la = -8.0f * r * spd; const float a = __expf(la); const float bm = sqrtf(-expm1f(2.f * la));
            acc[2 * d][t] = a; acc[2 * d + 1][t] = bm * ii * vown[t]; }
    }
    { float A = 1.f, B = 0.f;
#pragma unroll
        for (int t = 0; t < 16; ++t) { B = acc[0][t] * B + acc[1][t]; A *= acc[0][t]; }
        sub[((0 * 4 + tq) * 128 + ch) * 2] = A; sub[((0 * 4 + tq) * 128 + ch) * 2 + 1] = B;
        A = 1.f; B = 0.f;
#pragma unroll
        for (int t = 15; t >= 0; --t) { B = acc[2][t] * B + acc[3][t]; A *= acc[2][t]; }
        sub[((1 * 4 + tq) * 128 + ch) * 2] = A; sub[((1 * 4 + tq) * 128 + ch) * 2 + 1] = B; }
    __syncthreads();
    if (!final) {
        if (F.tid < 256) { const int dir = F.tid >> 7; float A = 1.f, B = 0.f;
#pragma unroll
            for (int s = 0; s < 4; ++s) { const int q = dir ? 3 - s : s; const float As = sub[((dir * 4 + q) * 128 + ch) * 2], Bs = sub[((dir * 4 + q) * 128 + ch) * 2 + 1]; B = As * B + Bs; A *= As; }
            float* dst = F.sum + ((size_t)(sc * 2 + dir) * 512 + cidx) * 2; dst[0] = A; dst[1] = B; }
        __syncthreads();
        return;
    }
    if (F.tid < 256) {
        const int dir = F.tid >> 7; float h = 0.f;
        const float* sb = F.sum + ((size_t)dir * 512 + cidx) * 2;
        if (dir == 0) {
            const int nctx = is_lat ? 4 : c;
            for (int cc = 0; cc < nctx; ++cc) { const float* p = sb + (size_t)(4 * b + cc) * 2048; h = p[0] * h + p[1]; }
            if (is_lat) for (int cc = 0; cc < c; ++cc) { const float* p = sb + (size_t)(8 + 128 * b + cc) * 2048; h = p[0] * h + p[1]; }
        } else {
            if (is_lat) { for (int cc = 3; cc >= 0; --cc) { const float* p = sb + (size_t)(4 * b + cc) * 2048; h = p[0] * h + p[1]; }
                for (int cc = 127; cc > c; --cc) { const float* p = sb + (size_t)(8 + 128 * b + cc) * 2048; h = p[0] * h + p[1]; } }
            else for (int cc = 3; cc > c; --cc) { const float* p = sb + (size_t)(4 * b + cc) * 2048; h = p[0] * h + p[1]; }
        }
        if (dir == 0) {
#pragma unroll
            for (int q = 0; q < 4; ++q) { cin[(0 * 4 + q) * 128 + ch] = h; h = sub[((0 * 4 + q) * 128 + ch) * 2] * h + sub[((0 * 4 + q) * 128 + ch) * 2 + 1]; }
        } else {
#pragma unroll
            for (int q = 3; q >= 0; --q) { cin[(1 * 4 + q) * 128 + ch] = h; h = sub[((1 * 4 + q) * 128 + ch) * 2] * h + sub[((1 * 4 + q) * 128 + ch) * 2 + 1]; }
        }
    }
    __syncthreads();
    {
        float y[16]; float h = cin[(0 * 4 + tq) * 128 + ch];
#pragma unroll
        for (int t = 0; t < 16; ++t) { h = acc[0][t] * h + acc[1][t]; y[t] = h; }
        h = cin[(1 * 4 + tq) * 128 + ch];
#pragma unroll
        for (int t = 15; t >= 0; --t) { h = acc[2][t] * h + acc[3][t]; y[t] += h; }
#pragma unroll
        for (int t = 0; t < 16; ++t) { const size_t row = (size_t)(seq0 + t0 + tq * 16 + t); const float g = bf2f(F.P[row * 2048 + 1536 + cidx]);
            F.XN[row * D + 512 + cidx] = (bf16)f2bf(y[t] * gelu_tanh(g)); }
    }
    __syncthreads();
}

__device__ __forceinline__ LAS int* build_tiles(Frame& F, int layer) {
    LAS int* ts = (LAS int*)(F.lds + TS_OFF);
    if (F.tid == 0) { int a = 0;
        for (int e = 0; e < 16; ++e) { const int c = (int)__hip_atomic_load(F.ctl + CW_CNT + layer * 64 + e, RLX_AGENT); ts[e] = a; ts[17 + e] = c; a += (c + 255) >> 8; }
        ts[16] = a; }
    __syncthreads();
    return ts;
}

__device__ __forceinline__ void route_phase(Frame& F, int layer, int nrows) {
    LAS float* RwT = (LAS float*)F.lds;
    LAS int* lcnt = (LAS int*)(F.lds + 65536);
    LAS int* lbase = lcnt + 16;
    LAS int* tabi = lbase + 16;
    LAS float* tabw = (LAS float*)(tabi + 512);
    for (int i = F.tid; i < 16384; i += NWAVES * 64) RwT[(i & 15) * 1024 + (i >> 4)] = F.router_w[i];
    if (F.tid < 16) lcnt[F.tid] = 0;
    __syncthreads();
    const int per = (nrows + F.G - 1) / F.G, tok0 = blockIdx.x * per;
    float rb[16];
#pragma unroll
    for (int e = 0; e < 16; ++e) rb[e] = F.router_bias[e];
    for (int ti = F.wave; ti < per; ti += NWAVES) {
        const int token = tok0 + ti; if (token >= nrows) break;
        const int mi = (token >> 13) > 2 ? 2 : (token >> 13);
        f32x4 v[4], t[4];
#pragma unroll
        for (int j = 0; j < 4; ++j) v[j] = *(const f32x4*)(F.H + (size_t)token * D + 4 * F.lane + 256 * j);
        const float* md = F.mod + (layer * 3 + mi) * 6144;
        norm_mod_store(v, F.gffn + layer * D, md + 4096, md + 3072, F.XN + (size_t)token * D, F.lane, t);
        float score[16], sel[16];
#pragma unroll
        for (int e = 0; e < 16; ++e) { float p = 0.f;
#pragma unroll
            for (int j = 0; j < 4; ++j) { const f32x4 w = *(const LAS f32x4*)(RwT + e * 1024 + 4 * F.lane + 256 * j); p += (t[j].x * w.x + t[j].y * w.y) + (t[j].z * w.z + t[j].w * w.w); }
            p = wave_sum(p); score[e] = 1.f / (1.f + expf(-p)); sel[e] = score[e] + rb[e]; }
        int bg = 0; float bgs = -INFINITY;
#pragma unroll
        for (int g = 0; g < 4; ++g) { const float a = sel[4 * g], bq = sel[4 * g + 1], cq = sel[4 * g + 2], dq = sel[4 * g + 3];
            const float gs = fmaxf(fmaxf(fmaxf(a + bq, a + cq), fmaxf(a + dq, bq + cq)), fmaxf(bq + dq, cq + dq));
            if (gs > bgs) { bgs = gs; bg = g; } }
        float s4[4], c4[4];
#pragma unroll
        for (int j = 0; j < 4; ++j) { s4[j] = sel[j]; c4[j] = score[j]; }
#pragma unroll
        for (int g = 1; g < 4; ++g)
#pragma unroll
            for (int j = 0; j < 4; ++j) { s4[j] = (bg == g) ? sel[4 * g + j] : s4[j]; c4[j] = (bg == g) ? score[4 * g + j] : c4[j]; }
        int i1 = 0; float v1 = s4[0], sc1 = c4[0];
#pragma unroll
        for (int j = 1; j < 4; ++j) if (s4[j] > v1) { v1 = s4[j]; i1 = j; sc1 = c4[j]; }
        int i2 = -1; float v2 = -INFINITY, sc2 = 0.f;
#pragma unroll
        for (int j = 0; j < 4; ++j) if (j != i1 && s4[j] > v2) { v2 = s4[j]; i2 = j; sc2 = c4[j]; }
        if (F.lane == 0) { const int e0 = 4 * bg + i1, e1 = 4 * bg + i2; const float inv = 1.f / (sc1 + sc2);
            const int p0 = __hip_atomic_fetch_add(lcnt + e0, 1, __ATOMIC_RELAXED, __HIP_MEMORY_SCOPE_WORKGROUP), p1 = __hip_atomic_fetch_add(lcnt + e1, 1, __ATOMIC_RELAXED, __HIP_MEMORY_SCOPE_WORKGROUP);
            tabi[ti * 4 + 0] = e0; tabi[ti * 4 + 1] = p0; tabi[ti * 4 + 2] = e1; tabi[ti * 4 + 3] = p1; tabw[ti * 2] = sc1 * inv; tabw[ti * 2 + 1] = sc2 * inv; }
    }
    __syncthreads();
    if (F.tid < 16) lbase[F.tid] = (int)__hip_atomic_fetch_add(F.ctl + CW_CNT + layer * 64 + F.tid, (unsigned)lcnt[F.tid], RLX_AGENT);
    __syncthreads();
    if (F.tid < per && tok0 + F.tid < nrows) { const int token = tok0 + F.tid;
#pragma unroll
        for (int k = 0; k < 2; ++k) { const int e = tabi[F.tid * 4 + 2 * k], idx = lbase[e] + tabi[F.tid * 4 + 2 * k + 1];
            F.list[(size_t)layer * 16 * CAP + e * CAP + idx] = token; F.rslot[((size_t)layer * MALL + token) * 2 + k] = e * CAP + idx; F.rw[((size_t)layer * MALL + token) * 2 + k] = tabw[F.tid * 2 + k]; } }
    __syncthreads();
}

__device__ __forceinline__ void combine_phase(Frame& F, int layer, int nrows, bool final) {
    LAS int* ts = build_tiles(F, layer);
    const int gw = F.vcu * NWAVES + F.wave, NGW = F.G * NWAVES;
    for (int row = gw; row < nrows; row += NGW) {
        const int mi = (row >> 13) > 2 ? 2 : (row >> 13);
        const int s0 = F.rslot[((size_t)layer * MALL + row) * 2], s1 = F.rslot[((size_t)layer * MALL + row) * 2 + 1];
        const float w0 = F.rw[((size_t)layer * MALL + row) * 2], w1 = F.rw[((size_t)layer * MALL + row) * 2 + 1];
        const int e0 = s0 / CAP, e1 = s1 / CAP;
        const size_t y0 = (size_t)(ts[e0] * 256 + (s0 - e0 * CAP)), y1 = (size_t)(ts[e1] * 256 + (s1 - e1 * CAP));
        const float* md = F.mod + (layer * 3 + mi) * 6144;
        f32x4 v[4], t[4];
#pragma unroll
        for (int j = 0; j < 4; ++j) { const int col = 4 * F.lane + 256 * j;
            const v2u a = *(const v2u*)(F.Y + y0 * D + col), bq = *(const v2u*)(F.Y + y1 * D + col);
            f32x4 fa, fb; fa.x = __uint_as_float(a.x << 16); fa.y = __uint_as_float(a.x & 0xffff0000u); fa.z = __uint_as_float(a.y << 16); fa.w = __uint_as_float(a.y & 0xffff0000u);
            fb.x = __uint_as_float(bq.x << 16); fb.y = __uint_as_float(bq.x & 0xffff0000u); fb.z = __uint_as_float(bq.y << 16); fb.w = __uint_as_float(bq.y & 0xffff0000u);
            const f32x4 g2 = *(const f32x4*)(md + 5120 + col);
            v[j] = *(const f32x4*)(F.H + (size_t)row * D + col) + g2 * (fa * w0 + fb * w1); }
        if (!final) {
#pragma unroll
            for (int j = 0; j < 4; ++j) *(f32x4*)(F.H + (size_t)row * D + 4 * F.lane + 256 * j) = v[j];
            const float* md1 = F.mod + ((layer + 1) * 3 + mi) * 6144;
            norm_mod_store(v, F.gmix + (layer + 1) * D, md1 + 1024, md1, F.XN + (size_t)row * D, F.lane, t);
        } else {
            float s = 0.f;
#pragma unroll
            for (int j = 0; j < 4; ++j) s += (v[j].x * v[j].x + v[j].y * v[j].y) + (v[j].z * v[j].z + v[j].w * v[j].w);
            const float rstd = 1.f / sqrtf(wave_sum(s) * (1.f / D) + EPS);
#pragma unroll
            for (int j = 0; j < 4; ++j) { const int col = 4 * F.lane + 256 * j; *(f32x4*)(F.out + (size_t)row * D + col) = v[j] * rstd * *(const f32x4*)(F.final_g + col); }
        }
    }
}

__device__ __forceinline__ void unpack8(const v4u w, float (&f)[8]) {
    f[0] = __uint_as_float(w.x << 16); f[1] = __uint_as_float(w.x & 0xffff0000u); f[2] = __uint_as_float(w.y << 16); f[3] = __uint_as_float(w.y & 0xffff0000u);
    f[4] = __uint_as_float(w.z << 16); f[5] = __uint_as_float(w.z & 0xffff0000u); f[6] = __uint_as_float(w.w << 16); f[7] = __uint_as_float(w.w & 0xffff0000u);
}
typedef __bf16 bf16x2_t __attribute__((ext_vector_type(2)));
__device__ __forceinline__ unsigned cvtpk(float lo, float hi) { f32x2 v = {lo, hi}; return __builtin_bit_cast(unsigned, __builtin_convertvector(v, bf16x2_t)); }
#define NAT_THR 8.0f
__device__ __forceinline__ void natten_task(Frame& F, int b, int h, int r, const LAS float* rpbL) {
    const int lane = F.lane, q = lane & 15, fq = lane >> 4;
    const int rs = (r - 4) < 0 ? 0 : ((r - 4) > NROWS - 8 ? NROWS - 8 : (r - 4));
    const size_t qrow0 = (size_t)b * SEQ + (size_t)r * GRIDW;
    bf16x8 Qf[4][2];
#pragma unroll
    for (int qb = 0; qb < 4; ++qb)
#pragma unroll
        for (int dh = 0; dh < 2; ++dh) Qf[qb][dh] = *(const bf16x8*)(F.P + (qrow0 + 16 * qb + q) * P1LD + 1536 + 64 * h + 32 * dh + 8 * fq);
    f32x4 OT[4][4]; float mrun[4], lrun[4]; int cbase[4], bbase[4];
#pragma unroll
    for (int qb = 0; qb < 4; ++qb) { const int c = 16 * qb + q; const int cs = (c - 8) < 0 ? 0 : ((c - 8) > GRIDW - 16 ? GRIDW - 16 : (c - 8));
        cbase[qb] = 4 * fq - cs; bbase[qb] = 4 * fq - c + 15; mrun[qb] = -INFINITY; lrun[qb] = 0.f;
#pragma unroll
        for (int db = 0; db < 4; ++db) OT[qb][db] = (f32x4){0.f, 0.f, 0.f, 0.f}; }
    const bf16* kbase = F.P + 2048 + 64 * h + 8 * fq;
    const bf16* vbase = F.VT + (size_t)(64 * h + q) * MALL + 4 * fq;
    for (int kk = 0; kk < 8; ++kk) {
        const int kr = rs + kk; const size_t krow0 = (size_t)b * SEQ + (size_t)kr * GRIDW;
        const LAS float* brow = rpbL + (h * 15 + (kr - r + 7)) * 31;
        bf16x8 Kf[4][2];
#pragma unroll
        for (int kb = 0; kb < 4; ++kb)
#pragma unroll
            for (int dh = 0; dh < 2; ++dh) Kf[kb][dh] = *(const bf16x8*)(kbase + (krow0 + 16 * kb + q) * P1LD + 32 * dh);
        f32x4 S[4][4];
#pragma unroll
        for (int qb = 0; qb < 4; ++qb) {
            constexpr int KB0[4] = {0, 0, 1, 2}, KB1[4] = {2, 3, 4, 4};
            float ml = -INFINITY;
#pragma unroll
            for (int kb = 0; kb < 4; ++kb) if (kb >= KB0[qb] && kb < KB1[qb]) {
                f32x4 a = __builtin_amdgcn_mfma_f32_16x16x32_bf16(Kf[kb][0], Qf[qb][0], (f32x4){0.f, 0.f, 0.f, 0.f}, 0, 0, 0);
                a = __builtin_amdgcn_mfma_f32_16x16x32_bf16(Kf[kb][1], Qf[qb][1], a, 0, 0, 0);
#pragma unroll
                for (int j = 0; j < 4; ++j) { const bool valid = (unsigned)(cbase[qb] + 16 * kb + j) < 16u; const float bias = brow[bbase[qb] + 16 * kb + j];
                    a[j] = valid ? a[j] + bias : -INFINITY; ml = fmaxf(ml, a[j]); }
                S[qb][kb] = a;
            }
            ml = fmaxf(ml, __shfl_xor(ml, 16)); ml = fmaxf(ml, __shfl_xor(ml, 32));
            if (__any(ml > mrun[qb] + NAT_THR)) { const float mn = fmaxf(mrun[qb], ml), al = __builtin_amdgcn_exp2f(mrun[qb] - mn); mrun[qb] = mn; lrun[qb] *= al;
#pragma unroll
                for (int db = 0; db < 4; ++db) OT[qb][db] = OT[qb][db] * al; }
            float ls = 0.f;
#pragma unroll
            for (int kb = 0; kb < 4; ++kb) if (kb >= KB0[qb] && kb < KB1[qb]) {
#pragma unroll
                for (int j = 0; j < 4; ++j) { const float p = __builtin_amdgcn_exp2f(S[qb][kb][j] - mrun[qb]); S[qb][kb][j] = p; ls += p; } }
            else S[qb][kb] = (f32x4){0.f, 0.f, 0.f, 0.f};
            lrun[qb] += ls;
        }
#pragma unroll
        for (int g = 0; g < 2; ++g) {
            bf16x8 Vf[4];
#pragma unroll
            for (int db = 0; db < 4; ++db) { const bf16* vp = vbase + (size_t)(16 * db) * MALL + krow0 + 32 * g; const v2u lo = *(const v2u*)vp, hi = *(const v2u*)(vp + 16);
                Vf[db] = __builtin_bit_cast(bf16x8, (v4u){lo.x, lo.y, hi.x, hi.y}); }
#pragma unroll
            for (int qb = 0; qb < 4; ++qb) {
                constexpr int GOK[4][2] = {{1, 0}, {1, 1}, {1, 1}, {0, 1}};
                if (GOK[qb][g]) {
                    const f32x4 s0 = S[qb][2 * g], s1 = S[qb][2 * g + 1];
                    const bf16x8 pt = __builtin_bit_cast(bf16x8, (v4u){cvtpk(s0[0], s0[1]), cvtpk(s0[2], s0[3]), cvtpk(s1[0], s1[1]), cvtpk(s1[2], s1[3])});
#pragma unroll
                    for (int db = 0; db < 4; ++db) OT[qb][db] = __builtin_amdgcn_mfma_f32_16x16x32_bf16(Vf[db], pt, OT[qb][db], 0, 0, 0);
                }
            }
        }
    }
    for (int g = 0; g < 8; ++g) {
        const size_t ct0 = (size_t)MLAT + (size_t)b * CTXL + 32 * g;
        bf16x8 Kf[2][2];
#pragma unroll
        for (int kb = 0; kb < 2; ++kb)
#pragma unroll
            for (int dh = 0; dh < 2; ++dh) Kf[kb][dh] = *(const bf16x8*)(kbase + (ct0 + 16 * kb + q) * P1LD + 32 * dh);
        bf16x8 Vf[4];
#pragma unroll
        for (int db = 0; db < 4; ++db) { const bf16* vp = vbase + (size_t)(16 * db) * MALL + ct0; const v2u lo = *(const v2u*)vp, hi = *(const v2u*)(vp + 16);
            Vf[db] = __builtin_bit_cast(bf16x8, (v4u){lo.x, lo.y, hi.x, hi.y}); }
#pragma unroll
        for (int qb = 0; qb < 4; ++qb) {
            f32x4 s0 = __builtin_amdgcn_mfma_f32_16x16x32_bf16(Kf[0][0], Qf[qb][0], (f32x4){0.f, 0.f, 0.f, 0.f}, 0, 0, 0);
            s0 = __builtin_amdgcn_mfma_f32_16x16x32_bf16(Kf[0][1], Qf[qb][1], s0, 0, 0, 0);
            f32x4 s1 = __builtin_amdgcn_mfma_f32_16x16x32_bf16(Kf[1][0], Qf[qb][0], (f32x4){0.f, 0.f, 0.f, 0.f}, 0, 0, 0);
            s1 = __builtin_amdgcn_mfma_f32_16x16x32_bf16(Kf[1][1], Qf[qb][1], s1, 0, 0, 0);
            float ml = fmaxf(fmaxf(fmaxf(s0[0], s0[1]), fmaxf(s0[2], s0[3])), fmaxf(fmaxf(s1[0], s1[1]), fmaxf(s1[2], s1[3])));
            ml = fmaxf(ml, __shfl_xor(ml, 16)); ml = fmaxf(ml, __shfl_xor(ml, 32));
            if (__any(ml > mrun[qb] + NAT_THR)) { const float mn = fmaxf(mrun[qb], ml), al = __builtin_amdgcn_exp2f(mrun[qb] - mn); mrun[qb] = mn; lrun[qb] *= al;
#pragma unroll
                for (int db = 0; db < 4; ++db) OT[qb][db] = OT[qb][db] * al; }
            float ls = 0.f;
#pragma unroll
            for (int j = 0; j < 4; ++j) { s0[j] = __builtin_amdgcn_exp2f(s0[j] - mrun[qb]); s1[j] = __builtin_amdgcn_exp2f(s1[j] - mrun[qb]); ls += s0[j] + s1[j]; }
            lrun[qb] += ls;
            const bf16x8 pt = __builtin_bit_cast(bf16x8, (v4u){cvtpk(s0[0], s0[1]), cvtpk(s0[2], s0[3]), cvtpk(s1[0], s1[1]), cvtpk(s1[2], s1[3])});
#pragma unroll
            for (int db = 0; db < 4; ++db) OT[qb][db] = __builtin_amdgcn_mfma_f32_16x16x32_bf16(Vf[db], pt, OT[qb][db], 0, 0, 0);
        }
    }
#pragma unroll
    for (int qb = 0; qb < 4; ++qb) { float l = lrun[qb]; l += __shfl_xor(l, 16); l += __shfl_xor(l, 32); const float il = 1.f / l;
        bf16* op = F.XN + (qrow0 + 16 * qb + q) * D + 512 + 64 * h + 4 * fq;
#pragma unroll
        for (int db = 0; db < 4; ++db) { const f32x4 o = OT[qb][db] * il; v2u w; w.x = cvtpk(o[0], o[1]); w.y = cvtpk(o[2], o[3]); *(v2u*)(op + 16 * db) = w; } }
}
__device__ __forceinline__ void natten_phase(Frame& F) {
    LAS float* rpbL = (LAS float*)(F.lds + 1024);
    for (int i = F.tid; i < 8 * 15 * 31; i += NWAVES * 64) rpbL[i] = F.d_rpb[i] * 1.4426950408889634f;
    __syncthreads();
    for (int t = F.vcu; t < 256; t += F.G) natten_task(F, t >> 7, (t >> 4) & 7, (t & 15) * 8 + F.wave, rpbL);
    const int gw = F.vcu * NWAVES + F.wave, NGW = F.G * NWAVES;
    for (int qi = gw; qi < MLAT; qi += NGW) {
        const int b = qi >> 13, tt = qi & 8191;
        const int ch0 = 8 * F.lane; float accv[8];
#pragma unroll
        for (int d = 0; d < 8; ++d) accv[d] = 0.f;
#pragma unroll
        for (int k = 0; k < 3; ++k) { const int t2 = tt + k - 1;
            if (t2 >= 0 && t2 < SEQ) { float xi[8], cg[8]; const bf16* p = F.P + ((size_t)b * SEQ + t2) * P1LD + ch0; unpack8(*(const v4u*)p, xi); unpack8(*(const v4u*)(p + 1024), cg);
#pragma unroll
                for (int d = 0; d < 8; ++d) accv[d] += F.c_conv_w[k * 512 + ch0 + d] * (cg[d] * xi[d]); } }
        float bgv[8]; unpack8(*(const v4u*)(F.P + (size_t)qi * P1LD + 512 + ch0), bgv);
        v4u w2; w2.x = pk2(bgv[0] * accv[0], bgv[1] * accv[1]); w2.y = pk2(bgv[2] * accv[2], bgv[3] * accv[3]); w2.z = pk2(bgv[4] * accv[4], bgv[5] * accv[5]); w2.w = pk2(bgv[6] * accv[6], bgv[7] * accv[7]);
        *(v4u*)(F.XN + (size_t)qi * D + ch0) = w2;
    }
}

struct Args { const float* in[28]; float* out; unsigned char* ws; int ph_lo, ph_hi; };
__global__ void __launch_bounds__(NWAVES * 64, 2) hybrid_fwd(Args args) {
    extern __shared__ __attribute__((aligned(16))) unsigned char lds[];
    Frame F;
    F.lds = (LAS unsigned char*)lds;
    F.MISC = (volatile LAS unsigned*)(F.lds + MISC_OFF);
    F.tid = threadIdx.x; F.lane = F.tid & 63; F.wave = __builtin_amdgcn_readfirstlane(F.tid >> 6);
    F.G = gridDim.x; { const int bx = blockIdx.x; F.vcu = (F.G % 8 == 0) ? (bx % 8) * (F.G / 8) + bx / 8 : bx; }
    unsigned char* ws = args.ws;
    F.ctl = (gu32*)(ws + WS_CTL);
    F.x = args.in[0]; F.c = args.in[1]; F.ctx = args.in[2]; F.c_ctx = args.in[3]; F.ada_w = args.in[4]; F.ada_b = args.in[5]; F.gmix = args.in[6]; F.gffn = args.in[7];
    F.w_out = args.in[8]; F.ab_w_in = args.in[9]; F.a_dw_w = args.in[10]; F.a_dw_b = args.in[11]; F.a_ln_g = args.in[12]; F.a_ln_b = args.in[13]; F.b_conv_w = args.in[14]; F.b_conv_b = args.in[15];
    F.b_gate_w = args.in[16]; F.b_gate_b = args.in[17]; F.b_lambda = args.in[18]; F.cd_w_in = args.in[19]; F.c_conv_w = args.in[20]; F.d_rpb = args.in[21]; F.router_w = args.in[22]; F.router_bias = args.in[23];
    F.moe_wg = args.in[24]; F.moe_wu = args.in[25]; F.moe_wd = args.in[26]; F.final_g = args.in[27]; F.out = args.out;
    F.mod = (float*)(ws + WS_MOD); F.sum = (float*)(ws + WS_SUM); F.list = (int*)(ws + WS_LIST); F.rslot = (int*)(ws + WS_RSLOT); F.rw = (float*)(ws + WS_RW);
    F.Wab = (bf16*)(ws + WS_WAB); F.Wout = (bf16*)(ws + WS_WOUT); F.Wcd = (bf16*)(ws + WS_WCD); F.Wgu = (bf16*)(ws + WS_WGU); F.Wd = (bf16*)(ws + WS_WD);
    F.XN = (bf16*)(ws + WS_XN); F.P = (bf16*)(ws + WS_P); F.Y = (bf16*)(ws + WS_Y); F.HID = (bf16*)(ws + WS_HID); F.VT = (bf16*)(ws + WS_VT); F.H = (float*)(ws + WS_H);
    for (int u = F.tid; u < (LDS_BYTES - LDSCTL_OFF) / 4; u += NWAVES * 64) ((LAS unsigned*)(F.lds + LDSCTL_OFF))[u] = 0u;
    __syncthreads();
    XcdBarrier bar; bar.bar = (unsigned*)(F.ctl + CW_BAR); bar.x = 0; bar.st = nullptr;
    const int lo = args.ph_lo, hi = args.ph_hi;
    const bool multi = (hi - lo) > 1;
    if (multi) bar = xcd_barrier_post((unsigned*)(F.ctl + CW_BAR), F.MISC + 8);
#define IN(k) (lo <= (k) && (k) < hi)
#define SEAM(k) do { if (IN(k) && IN((k) + 1)) xcd_barrier(bar); } while (0)
    const int bx = (int)blockIdx.x;

    if (IN(0)) { p0_prologue(F); } SEAM(0);
    if (IN(1)) { p1_norm0(F); } SEAM(1);
    if (IN(2)) {
        pg8::SchedPlain S; S.so.init(MALL / 256, 2048 / 256, F.G, bx); S.A = (const char*)F.XN; S.B = (const char*)F.Wab; S.tstep = (size_t)256 * 1024 * 2;
        pg8::EpiBf16 E{F.P, 2048};
        pg8::gemm_phase<pg8::EpiBf16, pg8::SchedPlain, true, true>(F.lds, 1024, S, E);
    } SEAM(2);
    if (IN(3)) {
        for (int u = F.vcu; u < MALL / 32; u += F.G) conf_unit(F, u);
        for (int u = F.vcu; u < 264 * 4; u += F.G) lru_unit(F, u, false);
    } SEAM(3);
    if (IN(4)) { for (int u = F.vcu; u < 264 * 4; u += F.G) lru_unit(F, u, true); } SEAM(4);
    if (IN(5)) {
        pg8::SchedPlain S; S.so.init(MALL / 256, 4, F.G, bx); S.A = (const char*)F.XN; S.B = (const char*)F.Wout; S.tstep = (size_t)256 * 1024 * 2;
        pg8::EpiRes E{F.x, F.H, F.H, F.mod + 0 * 3 * 6144 + 2048};
        pg8::gemm_phase<pg8::EpiRes, pg8::SchedPlain, true, true>(F.lds, 1024, S, E);
    } SEAM(5);
    if (IN(6)) { route_phase(F, 0, MALL); } SEAM(6);
    if (IN(7)) {
        LAS int* ts = build_tiles(F, 0);
        pg8::SchedMoeGU S; S.so.init(__builtin_amdgcn_readfirstlane(ts[16]), 4, F.G, bx); S.ts = ts; S.A = (const char*)F.XN; S.B = (const char*)F.Wgu; S.list = F.list;
        pg8::EpiGateUp E{F.HID};
        pg8::gemm_phase<pg8::EpiGateUp, pg8::SchedMoeGU, true, true>(F.lds, 1024, S, E);
    } SEAM(7);
    if (IN(8)) {
        LAS int* ts = build_tiles(F, 0);
        pg8::SchedMoeDown S; S.so.init(__builtin_amdgcn_readfirstlane(ts[16]), 4, F.G, bx); S.ts = ts; S.A = (const char*)F.HID; S.B = (const char*)F.Wd;
        pg8::EpiBf16 E{F.Y, 1024};
        pg8::gemm_phase<pg8::EpiBf16, pg8::SchedMoeDown, true, true>(F.lds, 512, S, E);
    } SEAM(8);
    if (IN(9)) { combine_phase(F, 0, MALL, false); } SEAM(9);
    if (IN(10)) {
        pg8::SchedInproj1 S; S.so.init(64, 10, F.G, bx); S.X = (const char*)F.XN; S.W = (const char*)F.Wcd; S.G = F.G; S.c = bx;
        pg8::EpiInproj1 E{F.P, F.VT};
        pg8::gemm_phase<pg8::EpiInproj1, pg8::SchedInproj1, true, true>(F.lds, 1024, S, E);
    } SEAM(10);
    if (IN(11)) { natten_phase(F); } SEAM(11);
    if (IN(12)) {
        pg8::SchedPlain S; S.so.init(MLAT / 256, 4, F.G, bx); S.A = (const char*)F.XN; S.B = (const char*)(F.Wout + (size_t)1024 * 1024); S.tstep = (size_t)256 * 1024 * 2;
        pg8::EpiRes E{F.H, F.H, F.H, F.mod + 1 * 3 * 6144 + 2048};
        pg8::gemm_phase<pg8::EpiRes, pg8::SchedPlain, true, true>(F.lds, 1024, S, E);
    } SEAM(12);
    if (IN(13)) { route_phase(F, 1, MLAT); } SEAM(13);
    if (IN(14)) {
        LAS int* ts = build_tiles(F, 1);
        pg8::SchedMoeGU S; S.so.init(__builtin_amdgcn_readfirstlane(ts[16]), 4, F.G, bx); S.ts = ts; S.A = (const char*)F.XN; S.B = (const char*)(F.Wgu + (size_t)16 * 1024 * 1024); S.list = F.list + (size_t)16 * CAP;
        pg8::EpiGateUp E{F.HID};
        pg8::gemm_phase<pg8::EpiGateUp, pg8::SchedMoeGU, true, true>(F.lds, 1024, S, E);
    } SEAM(14);
    if (IN(15)) {
        LAS int* ts = build_tiles(F, 1);
        pg8::SchedMoeDown S; S.so.init(__builtin_amdgcn_readfirstlane(ts[16]), 4, F.G, bx); S.ts = ts; S.A = (const char*)F.HID; S.B = (const char*)(F.Wd + (size_t)16 * 1024 * 512);
        pg8::EpiBf16 E{F.Y, 1024};
        pg8::gemm_phase<pg8::EpiBf16, pg8::SchedMoeDown, true, true>(F.lds, 512, S, E);
    } SEAM(15);
    if (IN(16)) { combine_phase(F, 1, MLAT, true); }
#undef IN
#undef SEAM
}

extern "C" void kernel_launch(void* const* d_in, const int* in_sizes, int n_in, void* d_out, int out_size, void* d_ws, size_t ws_size, hipStream_t stream) {
    static int grid = 0;
    if (grid == 0) {
        if (n_in != 28 || in_sizes[0] != MLAT * D || out_size != MLAT * D || ws_size < WS_END) {
            fprintf(stderr, "kernel_launch: unexpected shapes / workspace (n_in %d, in0 %d, out %d, ws %zu < %zu); nothing launched\n", n_in, n_in > 0 ? in_sizes[0] : -1, out_size, ws_size, (size_t)WS_END); grid = -1; return; }
        int dev = 0, cus = 0, per_cu = 0;
        if (hipGetDevice(&dev) != hipSuccess || hipDeviceGetAttribute(&cus, hipDeviceAttributeMultiprocessorCount, dev) != hipSuccess) { grid = -1; return; }
        if (hipFuncSetAttribute((const void*)hybrid_fwd, hipFuncAttributeMaxDynamicSharedMemorySize, LDS_BYTES) != hipSuccess) { fprintf(stderr, "kernel_launch: hipFuncSetAttribute failed\n"); grid = -1; return; }
        if (hipOccupancyMaxActiveBlocksPerMultiprocessor(&per_cu, (const void*)hybrid_fwd, NWAVES * 64, LDS_BYTES) != hipSuccess || per_cu < 1) { fprintf(stderr, "kernel_launch: occupancy query reports %d\n", per_cu); per_cu = 1; }
        (void)hipGetLastError();
        grid = cus;
        if (grid != 256) fprintf(stderr, "kernel_launch: %d CUs\n", grid);
    }
    if (grid < 0) return;
    if (hipMemsetAsync((char*)d_ws + WS_CTL, 0, CTL_ZERO_BYTES, stream) != hipSuccess) return;
    Args a{};
    for (int i = 0; i < 28; ++i) a.in[i] = (const float*)d_in[i];
    a.out = (float*)d_out; a.ws = (unsigned char*)d_ws;
    if (MK_N_LAUNCHES == 1) { a.ph_lo = 0; a.ph_hi = NPH; hipLaunchKernelGGL(hybrid_fwd, dim3(grid), dim3(NWAVES * 64), LDS_BYTES, stream, a); }
    else for (int p = 0; p < NPH; ++p) { a.ph_lo = p; a.ph_hi = p + 1; hipLaunchKernelGGL(hybrid_fwd, dim3(grid), dim3(NWAVES * 64), LDS_BYTES, stream, a); }
}
```

```cpp
#include <hip/hip_runtime.h>
#include <cstdio>
#include <cstdint>

#ifndef MK_N_LAUNCHES
#define MK_N_LAUNCHES 1
#endif

#define LAS __attribute__((address_space(3)))
#define GAS __attribute__((address_space(1)))
typedef unsigned short bf16;
typedef unsigned v4u __attribute__((ext_vector_type(4)));
typedef unsigned v2u __attribute__((ext_vector_type(2)));
typedef float f32x4 __attribute__((ext_vector_type(4)));
typedef float f32x2 __attribute__((ext_vector_type(2)));
typedef short bf16x8 __attribute__((ext_vector_type(8)));

constexpr int D = 1024, NBATCH = 2, SEQ = 8192, CTXL = 256;
constexpr int MLAT = NBATCH * SEQ;
constexpr int MCTX = NBATCH * CTXL;
constexpr int MALL = MLAT + MCTX;
constexpr int NEXP = 16, DFF = 512, CAP = MALL;
constexpr int GRIDW = 64, NROWS = SEQ / GRIDW;
constexpr float EPS = 1e-6f;
constexpr int NPH = 17;

constexpr size_t MiB = 1u << 20;
constexpr size_t WS_CTL = 0, CTL_ZERO_BYTES = 1 * MiB;
constexpr size_t WS_MOD = 1 * MiB;
constexpr size_t WS_SUM = 2 * MiB;
constexpr size_t WS_LIST = 5 * MiB;
constexpr size_t WS_RSLOT = 8 * MiB;
constexpr size_t WS_RW = 8 * MiB + 512 * 1024;
constexpr size_t WS_GATEW = 9 * MiB;
constexpr size_t WS_WAB = 10 * MiB;
constexpr size_t WS_WOUT = 14 * MiB;
constexpr size_t WS_WCD = 18 * MiB;
constexpr size_t WS_WGU = 24 * MiB;
constexpr size_t WS_WD = 88 * MiB;
constexpr size_t WS_XN = 120 * MiB;
constexpr size_t WS_H = 153 * MiB;
constexpr size_t WS_P = 219 * MiB;
constexpr int YROWS = 37632;
constexpr int P1LD = 2560;
constexpr size_t WS_VT = WS_P + (size_t)MALL * P1LD * 2;
constexpr float QSCALE = 0.125f * 1.4426950408889634f;
constexpr size_t WS_Y = WS_P, WS_HID = WS_P + (size_t)YROWS * 1024 * 2;
constexpr size_t WS_END = 330 * MiB;
static_assert(WS_HID + (size_t)YROWS * 512 * 2 <= WS_END, "ws map");
static_assert(WS_VT + (size_t)512 * MALL * 2 <= WS_END, "ws map");
constexpr int CW_BAR = 4096;
constexpr int CW_CNT = 16384;

constexpr int RING_BYTES = 131072;
constexpr int LDSCTL_OFF = RING_BYTES, MISC_OFF = LDSCTL_OFF + 320, TS_OFF = LDSCTL_OFF + 1024;
constexpr int LDS_BYTES = 147456;
constexpr int NWAVES = 8;

__device__ __forceinline__ float bf2f(bf16 b) { return __uint_as_float((unsigned)b << 16); }
__device__ __forceinline__ unsigned f2bf(float f) { unsigned u = __builtin_bit_cast(unsigned, f); return (u + 0x7fffu + ((u >> 16) & 1u)) >> 16; }
__device__ __forceinline__ unsigned pk2(float lo, float hi) { return f2bf(lo) | (f2bf(hi) << 16); }
__device__ __forceinline__ float sigm(float x) { return 1.f / (1.f + __expf(-x)); }
__device__ __forceinline__ float gelu_tanh(float x) { const float u = 0.7978845608028654f * (x + 0.044715f * x * x * x); return x * sigm(2.f * u); }
__device__ __forceinline__ float wave_sum(float v) {
#pragma unroll
    for (int o = 1; o < 64; o <<= 1) v += __shfl_xor(v, o);
    return v;
}
#define LDS_WAIT() asm volatile("s_waitcnt lgkmcnt(0)" ::: "memory")
#define RLX_AGENT __ATOMIC_RELAXED, __HIP_MEMORY_SCOPE_AGENT

namespace pg8 {
typedef unsigned short bf16_t;
typedef unsigned u32x4 __attribute__((ext_vector_type(4)));
constexpr int BM = 256, BK = 64, HALF = 128, HTB = HALF * BK * 2, STAGE_BYTES = 8 * HTB, NXCD = 8, WGM = 8;
__host__ __device__ __forceinline__ int lds_byte(int r, int c) { const int st = (r >> 4) * 2 + (c >> 5), rr = r & 15, cc = c & 31, ob = rr * 64 + cc * 2; return st * 1024 + (ob ^ (((ob >> 9) & 1) << 5)); }
__host__ __device__ __forceinline__ void stage_rc(int b, int& R, int& C) { const int st = b / 1024, sb = b % 1024, swz = sb ^ (((sb >> 9) & 1) << 5); R = (st >> 1) * 16 + swz / 64; C = (st & 1) * 32 + (swz % 64) / 2; }
__host__ __device__ __forceinline__ int perm32(int rho) { const int n = rho >> 4, i = rho & 15; return 8 * (i >> 2) + 4 * n + (i & 3); }

struct Unit { int pm, pn, e, r0, cnt; };

struct StaticOrder {
    int nM, nN, nwg, G, c;
    __device__ void init(int nM_, int nN_, int G_, int c_) { nM = nM_; nN = nN_; nwg = nM * nN; G = G_; c = c_; }
    __device__ bool next(int i, Unit& u) const {
        const long L = (long)i * G + c; if (L >= nwg) return false;
        int wgid = (int)L; { const int q = nwg / NXCD, r = nwg % NXCD, xcd = wgid % NXCD, off = wgid / NXCD; wgid = (xcd < r ? xcd * (q + 1) : r * (q + 1) + (xcd - r) * q) + off; }
        const int nig = WGM * nN, gid = wgid / nig, fm = gid * WGM, gsz = (nM - fm) < WGM ? (nM - fm) : WGM;
        u.pm = fm + ((wgid % nig) % gsz); u.pn = (wgid % nig) / gsz; u.e = 0; u.r0 = 0; u.cnt = 0; return true;
    }
};
struct SchedPlain {
    static constexpr bool GATHER = false;
    StaticOrder so; const char* A; const char* B; size_t tstep;
    __device__ __forceinline__ bool next(int i, Unit& u) const { return so.next(i, u); }
    __device__ __forceinline__ const char* a_ptr(const Unit& u) const { return A + (size_t)u.pm * tstep; }
    __device__ __forceinline__ const char* b_ptr(const Unit& u) const { return B + (size_t)u.pn * tstep; }
    __device__ __forceinline__ void a_offs(const Unit&, const int (&)[2], const int (&)[2], int, unsigned (&)[2][2]) const {}
};
struct SchedMoe {
    StaticOrder so; const LAS int* ts;
    __device__ __forceinline__ bool next(int i, Unit& u) const {
        if (!so.next(i, u)) return false;
        int e = 0;
#pragma unroll
        for (int j = 1; j < 16; ++j) e += (ts[j] <= u.pm) ? 1 : 0;
        e = __builtin_amdgcn_readfirstlane(e);
        u.e = e; u.r0 = (u.pm - __builtin_amdgcn_readfirstlane(ts[e])) * 256; u.cnt = __builtin_amdgcn_readfirstlane(ts[17 + e]); return true;
    }
};
struct SchedMoeGU : SchedMoe {
    static constexpr bool GATHER = true;
    const char* A; const char* B; const int* list;
    __device__ __forceinline__ const char* a_ptr(const Unit&) const { return A; }
    __device__ __forceinline__ const char* b_ptr(const Unit& u) const { return B + (size_t)u.e * (1024 * 1024 * 2) + (size_t)u.pn * (256 * 1024 * 2); }
    __device__ __forceinline__ void a_offs(const Unit& u, const int (&R)[2], const int (&C)[2], int K, unsigned (&v)[2][2]) const {
#pragma unroll
        for (int h = 0; h < 2; ++h)
#pragma unroll
            for (int i = 0; i < 2; ++i) { const int row = u.r0 + h * HALF + R[i]; int tok = 0; if (row < u.cnt) tok = list[u.e * CAP + row]; v[h][i] = (unsigned)(tok * K + C[i]) * 2u; }
    }
};
struct SchedMoeDown : SchedMoe {
    static constexpr bool GATHER = false;
    const char* A; const char* B;
    __device__ __forceinline__ const char* a_ptr(const Unit& u) const { return A + (size_t)u.pm * (256 * 512 * 2); }
    __device__ __forceinline__ const char* b_ptr(const Unit& u) const { return B + (size_t)u.e * (1024 * 512 * 2) + (size_t)u.pn * (256 * 512 * 2); }
    __device__ __forceinline__ void a_offs(const Unit&, const int (&)[2], const int (&)[2], int, unsigned (&)[2][2]) const {}
};

__device__ __forceinline__ unsigned cvt_pk_bf16(float lo, float hi) { unsigned r; asm volatile("v_cvt_pk_bf16_f32 %0, %1, %2" : "=v"(r) : "v"(lo), "v"(hi)); return r; }
struct EpiBf16 {
    static constexpr bool PERM = true;
    bf16_t* O; int ldc;
    __device__ __forceinline__ void operator()(const f32x4 (&acc)[2][2][4][2], const Unit& u, int wr, int wc, int fr, int fq) const {
        const int row0 = u.pm * BM + wr * 64 + fr, col0 = u.pn * BM + wc * 32 + 8 * fq;
#pragma unroll
        for (int ai = 0; ai < 2; ++ai)
#pragma unroll
            for (int m = 0; m < 4; ++m) { bf16_t* rowp = O + (size_t)(row0 + ai * HALF + m * 16) * ldc + col0;
#pragma unroll
                for (int bj = 0; bj < 2; ++bj) { const f32x4 v0 = acc[ai][bj][m][0], v1 = acc[ai][bj][m][1];
                    u32x4 w; w.x = cvt_pk_bf16(v0[0], v0[1]); w.y = cvt_pk_bf16(v0[2], v0[3]); w.z = cvt_pk_bf16(v1[0], v1[1]); w.w = cvt_pk_bf16(v1[2], v1[3]);
                    *(u32x4*)(rowp + bj * HALF) = w; } }
    }
};
struct EpiRes {
    static constexpr bool PERM = false;
    const float* hin_lat; const float* hin_ctx; float* hout; const float* gate;
    __device__ __forceinline__ void operator()(const f32x4 (&acc)[2][2][4][2], const Unit& u, int wr, int wc, int fr, int fq) const {
        const int row0 = u.pm * BM + wr * 64 + fr, col0 = u.pn * BM + wc * 32 + 4 * fq;
        const int mi = (u.pm >> 5) > 2 ? 2 : (u.pm >> 5);
        const float* src = (u.pm < 64) ? hin_lat : hin_ctx;
        f32x4 gv[2][2];
#pragma unroll
        for (int bj = 0; bj < 2; ++bj)
#pragma unroll
            for (int n = 0; n < 2; ++n) gv[bj][n] = *(const f32x4*)(gate + mi * 6144 + col0 + bj * HALF + n * 16);
#pragma unroll
        for (int ai = 0; ai < 2; ++ai)
#pragma unroll
            for (int m = 0; m < 4; ++m) { const size_t off = (size_t)(row0 + ai * HALF + m * 16) * D + col0;
#pragma unroll
                for (int bj = 0; bj < 2; ++bj)
#pragma unroll
                    for (int n = 0; n < 2; ++n) { const f32x4 b = *(const f32x4*)(src + off + bj * HALF + n * 16); *(f32x4*)(hout + off + bj * HALF + n * 16) = b + gv[bj][n] * acc[ai][bj][m][n]; } }
    }
};
struct EpiGateUp {
    static constexpr bool PERM = true;
    bf16_t* Hd;
    __device__ __forceinline__ void operator()(const f32x4 (&acc)[2][2][4][2], const Unit& u, int wr, int wc, int fr, int fq) const {
        const int row0 = u.pm * BM + wr * 64 + fr, col0 = u.pn * HALF + wc * 32 + 8 * fq;
#pragma unroll
        for (int ai = 0; ai < 2; ++ai)
#pragma unroll
            for (int m = 0; m < 4; ++m) { bf16_t* rowp = Hd + (size_t)(row0 + ai * HALF + m * 16) * DFF + col0;
                float h[8];
#pragma unroll
                for (int n = 0; n < 2; ++n)
#pragma unroll
                    for (int j = 0; j < 4; ++j) { const float g = acc[ai][0][m][n][j], up = acc[ai][1][m][n][j]; h[n * 4 + j] = g * sigm(g) * up; }
                u32x4 w; w.x = cvt_pk_bf16(h[0], h[1]); w.y = cvt_pk_bf16(h[2], h[3]); w.z = cvt_pk_bf16(h[4], h[5]); w.w = cvt_pk_bf16(h[6], h[7]);
                *(u32x4*)rowp = w; }
    }
};

struct SchedInproj1 {
    static constexpr bool GATHER = false;
    StaticOrder so; const char* X; const char* W; int G, c;
    __device__ __forceinline__ bool next(int i, Unit& u) const {
        const int L = i * G + c;
        if (L < 640) { return so.next(i, u); }
        if (L < 768) { const int idx = L - 640; u.pm = idx & 1; u.pn = idx >> 1; u.e = 1; u.r0 = 0; u.cnt = 0; return true; }
        if (L < 776) { const int idx = L - 768; if (idx < 4) { u.pm = 64 + (idx >> 1); u.pn = 8 + (idx & 1); u.e = 0; } else { u.pm = idx & 1; u.pn = 64 + ((idx >> 1) & 1); u.e = 1; } u.r0 = 0; u.cnt = 0; return true; }
        return false;
    }
    __device__ __forceinline__ const char* a_ptr(const Unit& u) const { return u.e ? W + (size_t)(10 + u.pm) * (256 * 1024 * 2) : X + (size_t)u.pm * (256 * 1024 * 2); }
    __device__ __forceinline__ const char* b_ptr(const Unit& u) const { return u.e ? X + (size_t)u.pn * (256 * 1024 * 2) : W + (size_t)u.pn * (256 * 1024 * 2); }
    __device__ __forceinline__ void a_offs(const Unit&, const int (&)[2], const int (&)[2], int, unsigned (&)[2][2]) const {}
};
struct EpiInproj1 {
    static constexpr bool PERM = true;
    bf16_t* P; bf16_t* VT;
    __device__ __forceinline__ void operator()(const f32x4 (&acc)[2][2][4][2], const Unit& u, int wr, int wc, int fr, int fq) const {
        const int row0 = u.pm * BM + wr * 64 + fr, col0 = u.pn * BM + wc * 32 + 8 * fq;
        bf16_t* O = u.e ? VT : P; const int ldc = u.e ? MALL : P1LD;
        const float sc = (!u.e && (u.pn == 6 || u.pn == 7)) ? QSCALE : 1.0f;
#pragma unroll
        for (int ai = 0; ai < 2; ++ai)
#pragma unroll
            for (int m = 0; m < 4; ++m) { bf16_t* rowp = O + (size_t)(row0 + ai * HALF + m * 16) * ldc + col0;
#pragma unroll
                for (int bj = 0; bj < 2; ++bj) { const f32x4 v0 = acc[ai][bj][m][0] * sc, v1 = acc[ai][bj][m][1] * sc;
                    u32x4 w; w.x = cvt_pk_bf16(v0[0], v0[1]); w.y = cvt_pk_bf16(v0[2], v0[3]); w.z = cvt_pk_bf16(v1[0], v1[1]); w.w = cvt_pk_bf16(v1[2], v1[3]);
                    *(u32x4*)(rowp + bj * HALF) = w; } }
    }
};

template <class Epi, class Sched, bool ALIGN_EPI, bool SP2>
__device__ __forceinline__ void gemm_phase(LAS unsigned char* lds, const int K, const Sched& S, const Epi& E) {
    const int tid = threadIdx.x, wid = __builtin_amdgcn_readfirstlane(tid >> 6), lane = tid & 63, wr = wid >> 2, wc = wid & 3, fr = lane & 15, fq = lane >> 4;
    const int nt = K / BK;
    const size_t kstep = (size_t)(BK * 2);
    const size_t hstep = (size_t)HALF * K * 2;
    int Rr[2], Cc[2]; unsigned voffB[2], vA[2][2], nvA[2][2];
#pragma unroll
    for (int i = 0; i < 2; ++i) { int R, C; stage_rc(tid * 16 + i * 8192, R, C); Rr[i] = R; Cc[i] = C; const int Rb = Epi::PERM ? ((R & ~31) + perm32(R & 31)) : R;
        voffB[i] = (unsigned)(Rb * K + C) * 2u; vA[0][i] = (unsigned)(R * K + C) * 2u; vA[1][i] = vA[0][i] + (unsigned)hstep; nvA[0][i] = vA[0][i]; nvA[1][i] = vA[1][i]; }
    const unsigned ldsw = (unsigned)wid * 1024u;
    const int aoff = lds_byte(wr * 64 + fr, fq * 8), boff = lds_byte(wc * 32 + fr, fq * 8);
#define PG8_SA(b, h) (((b) * 2 + (h)) * HTB)
#define PG8_SB(b, h) ((4 + (b) * 2 + (h)) * HTB)
#define PG8_STAGE(bufoff, gbase, voff) do { _Pragma("unroll") for (int _i = 0; _i < 2; ++_i) \
        __builtin_amdgcn_global_load_lds((const unsigned*)((const char*)(gbase) + (voff)[_i]), (LAS unsigned*)(lds + (bufoff) + ldsw + _i * 8192), 16, 0, 0); } while (0)
#define PG8_LDA(dst, b, h) do { _Pragma("unroll") for (int m = 0; m < 4; ++m) _Pragma("unroll") for (int k = 0; k < 2; ++k) dst[m][k] = *(const LAS bf16x8*)(lds + PG8_SA(b, h) + aoff + m * 2048 + k * 1024); } while (0)
#define PG8_LDB(dst, b, h) do { _Pragma("unroll") for (int n = 0; n < 2; ++n) _Pragma("unroll") for (int k = 0; k < 2; ++k) dst[n][k] = *(const LAS bf16x8*)(lds + PG8_SB(b, h) + boff + n * 2048 + k * 1024); } while (0)
#define PG8_MMA(ai, bj, At, Bt) do { __builtin_amdgcn_s_setprio(1); _Pragma("unroll") for (int m = 0; m < 4; ++m) _Pragma("unroll") for (int n = 0; n < 2; ++n) _Pragma("unroll") for (int k = 0; k < 2; ++k) \
        acc[ai][bj][m][n] = __builtin_amdgcn_mfma_f32_16x16x32_bf16(Bt[n][k], At[m][k], acc[ai][bj][m][n], 0, 0, 0); __builtin_amdgcn_s_setprio(0); } while (0)
#define PG8_WAIT_V(n) asm volatile("s_waitcnt vmcnt(" #n ")" ::: "memory")
#define PG8_WAIT_L(n) asm volatile("s_waitcnt lgkmcnt(" #n ")" ::: "memory")
#define PG8_BAR __builtin_amdgcn_s_barrier()
#define PG8_SCHED __builtin_amdgcn_sched_barrier(0)
    Unit cur, nxt; int ui = 0;
    if (!S.next(0, cur)) return;
    if constexpr (Sched::GATHER) { S.a_offs(cur, Rr, Cc, K, vA); }
    f32x4 acc[2][2][4][2];
#pragma unroll
    for (int a = 0; a < 2; ++a)
#pragma unroll
        for (int b = 0; b < 2; ++b)
#pragma unroll
            for (int m = 0; m < 4; ++m)
#pragma unroll
                for (int n = 0; n < 2; ++n) acc[a][b][m][n] = (f32x4){0.f, 0.f, 0.f, 0.f};
    bf16x8 At[4][2], B0[2][2], B1[2][2];
    const char* cA = S.a_ptr(cur); const char* cB = S.b_ptr(cur);
    static_assert(SP2, "only the two-super-phase loop is kept");
    PG8_STAGE(PG8_SB(0, 0), cB, voffB); PG8_STAGE(PG8_SB(0, 1), cB + hstep, voffB); PG8_STAGE(PG8_SA(0, 0), cA, vA[0]); PG8_STAGE(PG8_SA(0, 1), cA, vA[1]);
    if (wr == 1) PG8_BAR;
    PG8_WAIT_V(2); PG8_BAR;
    PG8_STAGE(PG8_SB(1, 0), cB + kstep, voffB); PG8_STAGE(PG8_SA(1, 0), cA + kstep, vA[0]); PG8_STAGE(PG8_SB(1, 1), cB + hstep + kstep, voffB);
    PG8_WAIT_V(6); PG8_BAR;
    for (;;) {
        const bool has_next = S.next(ui + 1, nxt);
        const char* nA = has_next ? S.a_ptr(nxt) : cA; const char* nB = has_next ? S.b_ptr(nxt) : cB;
        if constexpr (Sched::GATHER) { if (has_next) S.a_offs(nxt, Rr, Cc, K, nvA); }
        for (int t = 0; t < nt; t += 2) {
            const bool last = (t == nt - 2);
            const char* a1 = cA + (size_t)(t + 1) * kstep;
            const char* a2 = last ? nA : cA + (size_t)(t + 2) * kstep; const char* b2 = last ? nB : cB + (size_t)(t + 2) * kstep;
            const char* a3 = a2 + kstep; const char* b3 = b2 + kstep;
            unsigned wA[2][2];
#pragma unroll
            for (int h = 0; h < 2; ++h)
#pragma unroll
                for (int i = 0; i < 2; ++i) wA[h][i] = (Sched::GATHER && last) ? nvA[h][i] : vA[h][i];
            PG8_LDB(B0, 0, 0); PG8_LDB(B1, 0, 1); PG8_SCHED; PG8_LDA(At, 0, 0); PG8_STAGE(PG8_SA(1, 1), a1, vA[1]);
            PG8_WAIT_V(8); PG8_WAIT_L(0); PG8_BAR; PG8_MMA(0, 0, At, B0); PG8_MMA(0, 1, At, B1); PG8_BAR; PG8_SCHED;
            PG8_LDA(At, 0, 1); PG8_STAGE(PG8_SB(0, 0), b2, voffB); PG8_STAGE(PG8_SB(0, 1), b2 + hstep, voffB); PG8_STAGE(PG8_SA(0, 0), a2, wA[0]);
            PG8_WAIT_V(8); PG8_WAIT_L(0); PG8_BAR; PG8_MMA(1, 0, At, B0); PG8_MMA(1, 1, At, B1); PG8_BAR; PG8_SCHED;
            PG8_LDB(B0, 1, 0); PG8_LDB(B1, 1, 1); PG8_SCHED; PG8_LDA(At, 1, 0); PG8_STAGE(PG8_SA(0, 1), a2, wA[1]);
            PG8_WAIT_V(8); PG8_WAIT_L(0); PG8_BAR; PG8_MMA(0, 0, At, B0); PG8_MMA(0, 1, At, B1); PG8_BAR; PG8_SCHED;
            PG8_LDA(At, 1, 1); PG8_STAGE(PG8_SB(1, 0), b3, voffB); PG8_STAGE(PG8_SB(1, 1), b3 + hstep, voffB); PG8_STAGE(PG8_SA(1, 0), a3, wA[0]);
            PG8_WAIT_V(8); PG8_WAIT_L(0); PG8_BAR; PG8_MMA(1, 0, At, B0); PG8_MMA(1, 1, At, B1); PG8_BAR; PG8_SCHED;
        }
        if constexpr (ALIGN_EPI) { if (wr == 0) PG8_BAR; }
        E(acc, cur, wr, wc, fr, fq);
        if (!has_next) break;
#pragma unroll
        for (int a = 0; a < 2; ++a)
#pragma unroll
            for (int b = 0; b < 2; ++b)
#pragma unroll
                for (int m = 0; m < 4; ++m)
#pragma unroll
                    for (int n = 0; n < 2; ++n) acc[a][b][m][n] = (f32x4){0.f, 0.f, 0.f, 0.f};
        cur = nxt; cA = nA; cB = nB; ++ui;
        if constexpr (Sched::GATHER) {
#pragma unroll
            for (int h = 0; h < 2; ++h)
#pragma unroll
                for (int i = 0; i < 2; ++i) vA[h][i] = nvA[h][i];
        }
        if constexpr (ALIGN_EPI) { if (wr == 1) PG8_BAR; }
    }
    PG8_WAIT_V(0);
    if constexpr (!ALIGN_EPI) { if (wr == 0) PG8_BAR; }
    PG8_BAR;
#undef PG8_SA
#undef PG8_SB
#undef PG8_STAGE
#undef PG8_LDA
#undef PG8_LDB
#undef PG8_MMA
#undef PG8_WAIT_V
#undef PG8_WAIT_L
#undef PG8_BAR
#undef PG8_SCHED
}
}

typedef GAS unsigned gu32;
#define XB_TMO      128
#define XB_XCNT(j)  (256  + 64 * (j))
#define XB_XSUB(j)  (1280 + 64 * (j))
#define XB_XGEN(j)  (2304 + 64 * (j))
#define XB_TOP      3328
#define XB_TOPGEN   3392
#define XCD_BAR_WORDS 3456
#define XB_SPIN_CAP (1u << 20)
__device__ __forceinline__ unsigned xb_ld(unsigned* p)              { return __hip_atomic_load(p, __ATOMIC_RELAXED, __HIP_MEMORY_SCOPE_AGENT); }
__device__ __forceinline__ unsigned xb_add(unsigned* p, unsigned v) { return __hip_atomic_fetch_add(p, v, __ATOMIC_RELAXED, __HIP_MEMORY_SCOPE_AGENT); }
__device__ __forceinline__ unsigned xb_xcc_id() { return (unsigned)__builtin_amdgcn_s_getreg((3 << 11) | 20) & 0xFu; }
#define XB_SPIN(cond, bar) do { unsigned _sp = 0; while (cond) { __builtin_amdgcn_s_sleep(1); \
    if ((++_sp & 255u) == 0u) { if (xb_ld(&(bar)[XB_TMO])) break; if (_sp > XB_SPIN_CAP) { atomicAdd(&(bar)[XB_TMO], 1u); break; } } } } while (0)
struct XcdBarrier { unsigned* bar; unsigned x; volatile LAS unsigned* st; };
__device__ __forceinline__ XcdBarrier xcd_barrier_post(unsigned* bar, volatile LAS unsigned* st) {
    XcdBarrier b; b.bar = bar; b.x = xb_xcc_id(); b.st = st;
    if (threadIdx.x == 0) (void)xb_add(&bar[XB_XCNT(b.x)], 1u);
    return b;
}
__device__ __forceinline__ void xcd_barrier_complete(unsigned* bar, unsigned x, unsigned& nloc, unsigned& nx) {
    const unsigned G = gridDim.x * gridDim.y * gridDim.z;
    unsigned sum, cnt, mine, sp = 0u;
    for (;;) {
        sum = 0u; cnt = 0u; mine = 0u;
#pragma unroll
        for (unsigned j = 0; j < 16; ++j) { const unsigned c = xb_ld(&bar[XB_XCNT(j)]); sum += c; cnt += (c > 0u) ? 1u : 0u; mine = (j == x) ? c : mine; }
        if (sum == G) break;
        __builtin_amdgcn_s_sleep(1);
        if ((++sp & 255u) == 0u) { if (xb_ld(&bar[XB_TMO])) break; if (sp > XB_SPIN_CAP) { atomicAdd(&bar[XB_TMO], 1u); break; } }
    }
    nloc = mine > 0u ? mine : 1u; nx = cnt > 0u ? cnt : 1u;
}
__device__ __forceinline__ void xcd_barrier(const XcdBarrier& b) {
    asm volatile("s_waitcnt vmcnt(0)" ::: "memory");
    __syncthreads();
    if (threadIdx.x == 0) {
        unsigned* bar = b.bar;
        __builtin_amdgcn_s_waitcnt(0);
        unsigned nloc = b.st[0], nx = b.st[1];
        if (nloc == 0u) { xcd_barrier_complete(bar, b.x, nloc, nx); b.st[0] = nloc; b.st[1] = nx; }
        const unsigned old = xb_add(&bar[XB_XSUB(b.x)], 1u);
        const unsigned gen = old / nloc;
        if (old + 1u == (gen + 1u) * nloc) {
            __builtin_amdgcn_fence(__ATOMIC_RELEASE, "agent");
            asm volatile("s_waitcnt vmcnt(0)" ::: "memory");
            const unsigned og = xb_add(&bar[XB_TOP], 1u);
            const unsigned tg = og / nx;
            if (og + 1u == (tg + 1u) * nx) xb_add(&bar[XB_TOPGEN], 1u);
            else XB_SPIN(xb_ld(&bar[XB_TOPGEN]) == tg, bar);
            __builtin_amdgcn_fence(__ATOMIC_ACQUIRE, "agent");
            xb_add(&bar[XB_XGEN(b.x)], 1u);
            asm volatile("s_waitcnt vmcnt(0)" ::: "memory");
        } else {
            XB_SPIN(xb_ld(&bar[XB_XGEN(b.x)]) == gen, bar);
            __builtin_amdgcn_fence(__ATOMIC_ACQUIRE, "agent");
            asm volatile("s_waitcnt vmcnt(0)" ::: "memory");
        }
    }
    __syncthreads();
}

struct Frame {
    LAS unsigned char* lds;
    volatile LAS unsigned* MISC;
    gu32* ctl;
    int tid, lane, wave, vcu, G;
    const float *x, *c, *ctx, *c_ctx, *ada_w, *ada_b, *gmix, *gffn, *w_out, *ab_w_in, *a_dw_w, *a_dw_b, *a_ln_g, *a_ln_b, *b_conv_w, *b_conv_b, *b_gate_w, *b_gate_b, *b_lambda,
        *cd_w_in, *c_conv_w, *d_rpb, *router_w, *router_bias, *moe_wg, *moe_wu, *moe_wd, *final_g;
    float* out;
    float* mod; float* sum; int* list; int* rslot; float* rw;
    bf16 *Wab, *Wout, *Wcd, *Wgu, *Wd, *WgT;
    bf16 *XN, *P, *Y, *HID, *VT; float* H;
};

__device__ __forceinline__ void p0_transpose_item(const float* W, int K, int N, bf16* WT, int rbase, int rstride, LAS float* scr, int item, int lane) {
    const int nblk = N / 32, kb = item / nblk, nb = item % nblk, k0 = 64 * kb, n0 = 32 * nb;
    const int orow0 = rbase + (n0 >> 7) * rstride + (n0 & 127);
#pragma unroll 8
    for (int i = 0; i < 32; ++i) { const int kk = 2 * i + (lane >> 5); scr[kk * 33 + (lane & 31)] = W[(size_t)(k0 + kk) * N + n0 + (lane & 31)]; }
    LDS_WAIT(); asm volatile("" ::: "memory");
    const int c = lane & 7;
#pragma unroll
    for (int j = 0; j < 4; ++j) { const int n = (lane >> 3) + 8 * j; const LAS float* s = scr + (8 * c) * 33 + n;
        v4u o; o.x = pk2(s[0 * 33], s[1 * 33]); o.y = pk2(s[2 * 33], s[3 * 33]); o.z = pk2(s[4 * 33], s[5 * 33]); o.w = pk2(s[6 * 33], s[7 * 33]);
        *(GAS v4u*)(WT + (size_t)(orow0 + n) * K + k0 + 8 * c) = o; }
    LDS_WAIT(); asm volatile("" ::: "memory");
}

__device__ __forceinline__ void p0_prologue(Frame& F) {
    LAS float* condL = (LAS float*)F.lds;
    LAS float* red = condL + 3 * 1024;
    for (int i = F.tid; i < 3072; i += NWAVES * 64) { const int m = i >> 10, k = i & 1023; const float cv = (m < 2) ? F.c[m * 1024 + k] : F.c_ctx[k]; condL[i] = cv * sigm(cv); }
    __syncthreads();
    if (blockIdx.x < 192) {
        const int cg = blockIdx.x, layer = cg / 96, col0 = (cg % 96) * 64;
        const float* W = F.ada_w + (size_t)layer * 1024 * 6144 + col0 + F.lane;
        const int k0 = F.wave * 128;
        float a0 = 0.f, a1 = 0.f, a2 = 0.f;
#pragma unroll 8
        for (int kk = 0; kk < 128; ++kk) { const int k = k0 + kk; const float w = W[(size_t)k * 6144]; a0 += condL[k] * w; a1 += condL[1024 + k] * w; a2 += condL[2048 + k] * w; }
        red[(F.wave * 3 + 0) * 64 + F.lane] = a0; red[(F.wave * 3 + 1) * 64 + F.lane] = a1; red[(F.wave * 3 + 2) * 64 + F.lane] = a2;
        __syncthreads();
        if (F.tid < 192) { const int m = F.tid >> 6, l = F.tid & 63; float s = 0.f;
#pragma unroll
            for (int w = 0; w < 8; ++w) s += red[(w * 3 + m) * 64 + l];
            F.mod[(layer * 3 + m) * 6144 + col0 + l] = s + F.ada_b[layer * 6144 + col0 + l]; }
    }
    __syncthreads();
    LAS float* scr = (LAS float*)(F.lds + F.wave * 16384);
    const int gw = F.vcu * NWAVES + F.wave, NGW = F.G * NWAVES;
    constexpr int I_AB = 16 * 64, I_OUT = 16 * 32, I_CD = 16 * 96, I_G = 16 * 16, I_DN = 8 * 32;
    constexpr int I_GW = 2 * 4;
    constexpr int NITEMS = 16 * I_GW + I_AB + 2 * I_OUT + I_CD + 32 * (2 * I_G + I_DN);
    for (int it = gw; it < NITEMS; it += NGW) {
        int r = it;
        if (r < 16 * I_GW) { const int blk = r / I_GW; p0_transpose_item(F.b_gate_w + (size_t)blk * 16384, 128, 128, F.WgT + (size_t)blk * 16384, 0, 128, scr, r % I_GW, F.lane); continue; } r -= 16 * I_GW;
        if (r < I_AB) { p0_transpose_item(F.ab_w_in, 1024, 2048, F.Wab, 0, 128, scr, r, F.lane); continue; } r -= I_AB;
        if (r < 2 * I_OUT) { const int l = r / I_OUT; p0_transpose_item(F.w_out + (size_t)l * 1024 * 1024, 1024, 1024, F.Wout + (size_t)l * 1024 * 1024, 0, 128, scr, r % I_OUT, F.lane); continue; } r -= 2 * I_OUT;
        if (r < I_CD) { p0_transpose_item(F.cd_w_in, 1024, 3072, F.Wcd, 0, 128, scr, r, F.lane); continue; } r -= I_CD;
        if (r < 32 * I_G) { const int le = r / I_G; p0_transpose_item(F.moe_wg + (size_t)le * 1024 * 512, 1024, 512, F.Wgu + (size_t)le * 1024 * 1024, 0, 256, scr, r % I_G, F.lane); continue; } r -= 32 * I_G;
        if (r < 32 * I_G) { const int le = r / I_G; p0_transpose_item(F.moe_wu + (size_t)le * 1024 * 512, 1024, 512, F.Wgu + (size_t)le * 1024 * 1024, 128, 256, scr, r % I_G, F.lane); continue; } r -= 32 * I_G;
        { const int le = r / I_DN; p0_transpose_item(F.moe_wd + (size_t)le * 512 * 1024, 512, 1024, F.Wd + (size_t)le * 1024 * 512, 0, 128, scr, r % I_DN, F.lane); }
    }
}

__device__ __forceinline__ void norm_mod_store(const f32x4 (&v)[4], const float* g, const float* sc, const float* sh, bf16* dst, int lane, f32x4 (&t)[4]) {
    float s = 0.f;
#pragma unroll
    for (int j = 0; j < 4; ++j) s += (v[j].x * v[j].x + v[j].y * v[j].y) + (v[j].z * v[j].z + v[j].w * v[j].w);
    const float rstd = 1.f / sqrtf(wave_sum(s) * (1.f / D) + EPS);
#pragma unroll
    for (int j = 0; j < 4; ++j) { const int col = 4 * lane + 256 * j;
        const f32x4 gg = *(const f32x4*)(g + col), ss = *(const f32x4*)(sc + col), hh = *(const f32x4*)(sh + col);
        t[j] = v[j] * rstd * gg * (ss + 1.0f) + hh;
        v2u o; o.x = pk2(t[j].x, t[j].y); o.y = pk2(t[j].z, t[j].w);
        *(v2u*)(dst + col) = o; }
}

__device__ __forceinline__ void p1_norm0(Frame& F) {
    const int gw = F.vcu * NWAVES + F.wave, NGW = F.G * NWAVES;
    for (int row = gw; row < MALL; row += NGW) {
        const float* src = (row < MLAT) ? F.x + (size_t)row * D : F.ctx + (size_t)(row - MLAT) * D;
        const int mi = (row >> 13) > 2 ? 2 : (row >> 13);
        f32x4 v[4], t[4];
#pragma unroll
        for (int j = 0; j < 4; ++j) v[j] = *(const f32x4*)(src + 4 * F.lane + 256 * j);
        const float* md = F.mod + (0 * 3 + mi) * 6144;
        norm_mod_store(v, F.gmix, md + 1024, md, F.XN + (size_t)row * D, F.lane, t);
        if (row >= MLAT) {
#pragma unroll
            for (int j = 0; j < 4; ++j) *(f32x4*)(F.H + (size_t)row * D + 4 * F.lane + 256 * j) = v[j];
        }
    }
}

__device__ __forceinline__ void conf_unit(Frame& F, int u) {
    const int row0 = u * 32; int seq0, L;
    if (row0 < MLAT) { seq0 = (row0 >> 13) << 13; L = SEQ; } else { seq0 = MLAT + (((row0 - MLAT) >> 8) << 8); L = CTXL; }
    const int t0 = row0 - seq0, ch = F.tid;
    float uu[62];
#pragma unroll
    for (int tt = 0; tt < 62; ++tt) { const int t = t0 - 15 + tt; float val = 0.f;
        if (t >= 0 && t < L) { const bf16* p = F.P + (size_t)(seq0 + t) * 2048 + ch; const float v = bf2f(p[0]), g = bf2f(p[512]); val = v * sigm(g); }
        uu[tt] = val; }
    float o[32]; const float bias = F.a_dw_b[ch];
#pragma unroll
    for (int t = 0; t < 32; ++t) o[t] = bias;
#pragma unroll
    for (int k = 0; k < 31; ++k) { const float w = F.a_dw_w[k * 512 + ch];
#pragma unroll
        for (int t = 0; t < 32; ++t) o[t] += w * uu[t + k]; }
    LAS float* red = (LAS float*)F.lds;
    LAS float* fin = red + 512;
    float mine = 0.f;
#pragma unroll
    for (int t = 0; t < 32; ++t) { const float s = wave_sum(o[t]), q = wave_sum(o[t] * o[t]); mine = (F.lane == t) ? s : mine; mine = (F.lane == 32 + t) ? q : mine; }
    red[F.wave * 64 + F.lane] = mine;
    __syncthreads();
    if (F.tid < 64) { float s = 0.f;
#pragma unroll
        for (int w = 0; w < 8; ++w) s += red[w * 64 + F.tid];
        fin[F.tid] = s; }
    __syncthreads();
    const float lg = F.a_ln_g[ch], lb = F.a_ln_b[ch];
#pragma unroll
    for (int t = 0; t < 32; ++t) { const float mean = fin[t] * (1.f / 512.f); float var = fin[32 + t] * (1.f / 512.f) - mean * mean; var = var < 0.f ? 0.f : var;
        const float y = (o[t] - mean) * (1.f / sqrtf(var + EPS)) * lg + lb;
        F.XN[(size_t)(row0 + t) * D + ch] = (bf16)f2bf(y * sigm(y)); }
    __syncthreads();
}

typedef float f32x16 __attribute__((ext_vector_type(16)));
constexpr int LRU_VSB = 0, LRU_PRE = 20480, LRU_SUB = LRU_PRE + 65536, LRU_CIN = LRU_SUB + 8192, LRU_CAR = LRU_CIN + 4096, LRU_TMP = LRU_CAR + 4096;
__device__ __forceinline__ void lru_carries(Frame& F, int b, int n, bool is_lat, int c0, int nch) {
    LAS float* car = (LAS float*)(F.lds + LRU_CAR);
    LAS float* tmp = (LAS float*)(F.lds + LRU_TMP);
    const int ch = F.tid & 127, dir = (F.tid >> 7) & 1, half = F.tid >> 8, cidx = 128 * n + ch;
    const int nlat_all = is_lat ? 128 : 0, nctx = is_lat ? 4 : 0;
    const int top = is_lat ? 127 : 3;
    const int nown = dir ? (top - (c0 + nch - 1)) : c0;
    const int Ltot = nctx + nown, mid = Ltot >> 1;
    const int i0 = half ? mid : 0, i1 = half ? Ltot : mid;
    const float* sb = F.sum + ((size_t)dir * 512 + cidx) * 2;
    float A = 1.f, B = 0.f;
    for (int i = i0; i < i1; ++i) {
        int scn;
        if (i < nctx) scn = 4 * b + (dir ? 3 - i : i);
        else { const int k = i - nctx; const int cc = dir ? top - k : k; scn = is_lat ? 8 + 128 * b + cc : 4 * b + cc; }
        const float* p = sb + (size_t)scn * 2048; const float As = p[0], Bs = p[1]; B = As * B + Bs; A *= As;
    }
    if (half == 0) tmp[F.tid] = B;
    __syncthreads();
    if (half == 1) {
        float h = A * tmp[F.tid - 256] + B;
        if (dir == 0) { for (int i = 0; i < nch; ++i) { car[(i * 2 + 0) * 128 + ch] = h; const int scn = is_lat ? 8 + 128 * b + c0 + i : 4 * b + c0 + i; const float* p = sb + (size_t)scn * 2048; h = p[0] * h + p[1]; } }
        else { for (int i = nch - 1; i >= 0; --i) { car[(i * 2 + 1) * 128 + ch] = h; const int scn = is_lat ? 8 + 128 * b + c0 + i : 4 * b + c0 + i; const float* p = sb + (size_t)scn * 2048; h = p[0] * h + p[1]; } }
    }
    __syncthreads();
}
__device__ __forceinline__ void lru_chunk(Frame& F, int b, int n, bool is_lat, int c, int ci, bool final) {
    const int sc = is_lat ? 8 + 128 * b + c : 4 * b + c;
    const int seq0 = is_lat ? b * SEQ : MLAT + b * CTXL, L = is_lat ? SEQ : CTXL;
    const int t0 = c * 64, ch = F.tid & 127, tq = F.tid >> 7, cidx = 128 * n + ch;
    LAS bf16* vsb = (LAS bf16*)(F.lds + LRU_VSB);
    LAS float* pre = (LAS float*)(F.lds + LRU_PRE);
    LAS float* sub = (LAS float*)(F.lds + LRU_SUB);
    LAS float* cin = (LAS float*)(F.lds + LRU_CIN);
    const LAS float* car = (const LAS float*)(F.lds + LRU_CAR);
    float vown[16];
    {
        float uu[19];
#pragma unroll
        for (int tt = 0; tt < 19; ++tt) { const int t = t0 + tq * 16 + tt - 2; uu[tt] = (t >= 0 && t < L) ? bf2f(F.P[(size_t)(seq0 + t) * 2048 + 1024 + cidx]) : 0.f; }
        const float w0 = F.b_conv_w[cidx], w1 = F.b_conv_w[512 + cidx], w2 = F.b_conv_w[1024 + cidx], w3 = F.b_conv_w[1536 + cidx], cb = F.b_conv_b[cidx];
#pragma unroll
        for (int t = 0; t < 16; ++t) { vown[t] = cb + w0 * uu[t] + w1 * uu[t + 1] + w2 * uu[t + 2] + w3 * uu[t + 3]; vsb[(tq * 16 + t) * 136 + ch] = (bf16)f2bf(vown[t]); }
    }
    __syncthreads();
    float acc[4][16];
    {
        const int g = F.wave & 1, th = (F.wave >> 1) & 1, chh = F.wave >> 2, l31 = F.lane & 31, hk = F.lane >> 5;
        bf16x8 Af[8];
#pragma unroll
        for (int ks = 0; ks < 8; ++ks) Af[ks] = *(const LAS bf16x8*)(vsb + (32 * th + l31) * 136 + 16 * ks + 8 * hk);
#pragma unroll
        for (int d = 0; d < 2; ++d) {
            const bf16* wt = F.WgT + ((size_t)((d * 2 + g) * 4 + n) * 128 + 64 * chh + l31) * 128 + 8 * hk;
#pragma unroll
            for (int cb = 0; cb < 2; ++cb) {
                f32x16 a16 = {0.f, 0.f, 0.f, 0.f, 0.f, 0.f, 0.f, 0.f, 0.f, 0.f, 0.f, 0.f, 0.f, 0.f, 0.f, 0.f};
#pragma unroll
                for (int ks = 0; ks < 8; ++ks) { const bf16x8 Bf = *(const bf16x8*)(wt + (size_t)(32 * cb) * 128 + 16 * ks); a16 = __builtin_amdgcn_mfma_f32_32x32x16_bf16(Af[ks], Bf, a16, 0, 0, 0); }
#pragma unroll
                for (int r = 0; r < 16; ++r) pre[(g * 64 + 32 * th + (r & 3) + 8 * (r >> 2) + 4 * hk) * 128 + 64 * chh + 32 * cb + l31] = a16[r];
            }
            __syncthreads();
            const float lam = F.b_lambda[d * 512 + cidx]; const float spd = log1pf(__expf(-lam));
            const float br = F.b_gate_b[(d * 2 + 0) * 512 + cidx], bi = F.b_gate_b[(d * 2 + 1) * 512 + cidx];
#pragma unroll
            for (int t = 0; t < 16; ++t) { const float r = sigm(pre[(tq * 16 + t) * 128 + ch] + br), ii = sigm(pre[(64 + tq * 16 + t) * 128 + ch] + bi);
                const float la = -8.0f * r * spd; const float a = __expf(la); const float bm = sqrtf(fmaxf(1.f - a * a, 0.f));
                acc[2 * d][t] = a; acc[2 * d + 1][t] = bm * ii * vown[t]; }
            __syncthreads();
        }
    }
    { float A = 1.f, B = 0.f;
#pragma unroll
        for (int t = 0; t < 16; ++t) { B = acc[0][t] * B + acc[1][t]; A *= acc[0][t]; }
        sub[((0 * 4 + tq) * 128 + ch) * 2] = A; sub[((0 * 4 + tq) * 128 + ch) * 2 + 1] = B;
        A = 1.f; B = 0.f;
#pragma unroll
        for (int t = 15; t >= 0; --t) { B = acc[2][t] * B + acc[3][t]; A *= acc[2][t]; }
        sub[((1 * 4 + tq) * 128 + ch) * 2] = A; sub[((1 * 4 + tq) * 128 + ch) * 2 + 1] = B; }
    __syncthreads();
    if (!final) {
        if (F.tid < 256) { const int dir = F.tid >> 7; float A = 1.f, B = 0.f;
#pragma unroll
            for (int s = 0; s < 4; ++s) { const int q = dir ? 3 - s : s; const float As = sub[((dir * 4 + q) * 128 + ch) * 2], Bs = sub[((dir * 4 + q) * 128 + ch) * 2 + 1]; B = As * B + Bs; A *= As; }
            float* dst = F.sum + ((size_t)(sc * 2 + dir) * 512 + cidx) * 2; dst[0] = A; dst[1] = B; }
        __syncthreads();
        return;
    }
    if (F.tid < 256) {
        const int dir = F.tid >> 7; float h = car[(ci * 2 + dir) * 128 + ch];
        if (dir == 0) {
#pragma unroll
            for (int q = 0; q < 4; ++q) { cin[(0 * 4 + q) * 128 + ch] = h; h = sub[((0 * 4 + q) * 128 + ch) * 2] * h + sub[((0 * 4 + q) * 128 + ch) * 2 + 1]; }
        } else {
#pragma unroll
            for (int q = 3; q >= 0; --q) { cin[(1 * 4 + q) * 128 + ch] = h; h = sub[((1 * 4 + q) * 128 + ch) * 2] * h + sub[((1 * 4 + q) * 128 + ch) * 2 + 1]; }
        }
    }
    __syncthreads();
    {
        float y[16]; float h = cin[(0 * 4 + tq) * 128 + ch];
#pragma unroll
        for (int t = 0; t < 16; ++t) { h = acc[0][t] * h + acc[1][t]; y[t] = h; }
        h = cin[(1 * 4 + tq) * 128 + ch];
#pragma unroll
        for (int t = 15; t >= 0; --t) { h = acc[2][t] * h + acc[3][t]; y[t] += h; }
#pragma unroll
        for (int t = 0; t < 16; ++t) { const size_t row = (size_t)(seq0 + t0 + tq * 16 + t); const float g = bf2f(F.P[row * 2048 + 1536 + cidx]);
            F.XN[row * D + 512 + cidx] = (bf16)f2bf(y[t] * gelu_tanh(g)); }
    }
    __syncthreads();
}
__device__ __forceinline__ void lru_phase(Frame& F, bool final) {
    for (int gi = F.vcu; gi < 256 + 32; gi += F.G) {
        if (gi < 256) { const int b = gi >> 7, n = (gi >> 5) & 3, c0 = (gi & 31) * 4;
            if (final) lru_carries(F, b, n, true, c0, 4);
            for (int i = 0; i < 4; ++i) lru_chunk(F, b, n, true, c0 + i, i, final);
        } else { const int k = gi - 256, b = k >> 4, n = (k >> 2) & 3, c = k & 3;
            if (final) lru_carries(F, b, n, false, c, 1);
            lru_chunk(F, b, n, false, c, 0, final);
        }
    }
}

__device__ __forceinline__ LAS int* build_tiles(Frame& F, int layer) {
    LAS int* ts = (LAS int*)(F.lds + TS_OFF);
    if (F.tid == 0) { int a = 0;
        for (int e = 0; e < 16; ++e) { const int c = (int)__hip_atomic_load(F.ctl + CW_CNT + layer * 64 + e, RLX_AGENT); ts[e] = a; ts[17 + e] = c; a += (c + 255) >> 8; }
        ts[16] = a; }
    __syncthreads();
    return ts;
}

__device__ __forceinline__ void route_phase(Frame& F, int layer, int nrows) {
    LAS float* RwT = (LAS float*)F.lds;
    LAS int* lcnt = (LAS int*)(F.lds + 65536);
    LAS int* lbase = lcnt + 16;
    LAS int* tabi = lbase + 16;
    LAS float* tabw = (LAS float*)(tabi + 512);
    for (int i = F.tid; i < 16384; i += NWAVES * 64) RwT[(i & 15) * 1024 + (i >> 4)] = F.router_w[i];
    if (F.tid < 16) lcnt[F.tid] = 0;
    __syncthreads();
    const int per = (nrows + F.G - 1) / F.G, tok0 = blockIdx.x * per;
    float rb[16];
#pragma unroll
    for (int e = 0; e < 16; ++e) rb[e] = F.router_bias[e];
    for (int ti = F.wave; ti < per; ti += NWAVES) {
        const int token = tok0 + ti; if (token >= nrows) break;
        const int mi = (token >> 13) > 2 ? 2 : (token >> 13);
        f32x4 v[4], t[4];
#pragma unroll
        for (int j = 0; j < 4; ++j) v[j] = *(const f32x4*)(F.H + (size_t)token * D + 4 * F.lane + 256 * j);
        const float* md = F.mod + (layer * 3 + mi) * 6144;
        norm_mod_store(v, F.gffn + layer * D, md + 4096, md + 3072, F.XN + (size_t)token * D, F.lane, t);
        float score[16], sel[16];
#pragma unroll
        for (int e = 0; e < 16; ++e) { float p = 0.f;
#pragma unroll
            for (int j = 0; j < 4; ++j) { const f32x4 w = *(const LAS f32x4*)(RwT + e * 1024 + 4 * F.lane + 256 * j); p += (t[j].x * w.x + t[j].y * w.y) + (t[j].z * w.z + t[j].w * w.w); }
            p = wave_sum(p); score[e] = 1.f / (1.f + expf(-p)); sel[e] = score[e] + rb[e]; }
        int bg = 0; float bgs = -INFINITY;
#pragma unroll
        for (int g = 0; g < 4; ++g) { const float a = sel[4 * g], bq = sel[4 * g + 1], cq = sel[4 * g + 2], dq = sel[4 * g + 3];
            const float gs = fmaxf(fmaxf(fmaxf(a + bq, a + cq), fmaxf(a + dq, bq + cq)), fmaxf(bq + dq, cq + dq));
            if (gs > bgs) { bgs = gs; bg = g; } }
        float s4[4], c4[4];
#pragma unroll
        for (int j = 0; j < 4; ++j) { s4[j] = sel[j]; c4[j] = score[j]; }
#pragma unroll
        for (int g = 1; g < 4; ++g)
#pragma unroll
            for (int j = 0; j < 4; ++j) { s4[j] = (bg == g) ? sel[4 * g + j] : s4[j]; c4[j] = (bg == g) ? score[4 * g + j] : c4[j]; }
        int i1 = 0; float v1 = s4[0], sc1 = c4[0];
#pragma unroll
        for (int j = 1; j < 4; ++j) if (s4[j] > v1) { v1 = s4[j]; i1 = j; sc1 = c4[j]; }
        int i2 = -1; float v2 = -INFINITY, sc2 = 0.f;
#pragma unroll
        for (int j = 0; j < 4; ++j) if (j != i1 && s4[j] > v2) { v2 = s4[j]; i2 = j; sc2 = c4[j]; }
        if (F.lane == 0) { const int e0 = 4 * bg + i1, e1 = 4 * bg + i2; const float inv = 1.f / (sc1 + sc2);
            const int p0 = __hip_atomic_fetch_add(lcnt + e0, 1, __ATOMIC_RELAXED, __HIP_MEMORY_SCOPE_WORKGROUP), p1 = __hip_atomic_fetch_add(lcnt + e1, 1, __ATOMIC_RELAXED, __HIP_MEMORY_SCOPE_WORKGROUP);
            tabi[ti * 4 + 0] = e0; tabi[ti * 4 + 1] = p0; tabi[ti * 4 + 2] = e1; tabi[ti * 4 + 3] = p1; tabw[ti * 2] = sc1 * inv; tabw[ti * 2 + 1] = sc2 * inv; }
    }
    __syncthreads();
    if (F.tid < 16) lbase[F.tid] = (int)__hip_atomic_fetch_add(F.ctl + CW_CNT + layer * 64 + F.tid, (unsigned)lcnt[F.tid], RLX_AGENT);
    __syncthreads();
    if (F.tid < per && tok0 + F.tid < nrows) { const int token = tok0 + F.tid;
#pragma unroll
        for (int k = 0; k < 2; ++k) { const int e = tabi[F.tid * 4 + 2 * k], idx = lbase[e] + tabi[F.tid * 4 + 2 * k + 1];
            F.list[(size_t)layer * 16 * CAP + e * CAP + idx] = token; F.rslot[((size_t)layer * MALL + token) * 2 + k] = e * CAP + idx; F.rw[((size_t)layer * MALL + token) * 2 + k] = tabw[F.tid * 2 + k]; } }
    __syncthreads();
}

__device__ __forceinline__ void combine_phase(Frame& F, int layer, int nrows, bool final) {
    LAS int* ts = build_tiles(F, layer);
    const int gw = F.vcu * NWAVES + F.wave, NGW = F.G * NWAVES;
    for (int row = gw; row < nrows; row += NGW) {
        const int mi = (row >> 13) > 2 ? 2 : (row >> 13);
        const int s0 = F.rslot[((size_t)layer * MALL + row) * 2], s1 = F.rslot[((size_t)layer * MALL + row) * 2 + 1];
        const float w0 = F.rw[((size_t)layer * MALL + row) * 2], w1 = F.rw[((size_t)layer * MALL + row) * 2 + 1];
        const int e0 = s0 / CAP, e1 = s1 / CAP;
        const size_t y0 = (size_t)(ts[e0] * 256 + (s0 - e0 * CAP)), y1 = (size_t)(ts[e1] * 256 + (s1 - e1 * CAP));
        const float* md = F.mod + (layer * 3 + mi) * 6144;
        f32x4 v[4], t[4];
#pragma unroll
        for (int j = 0; j < 4; ++j) { const int col = 4 * F.lane + 256 * j;
            const v2u a = *(const v2u*)(F.Y + y0 * D + col), bq = *(const v2u*)(F.Y + y1 * D + col);
            f32x4 fa, fb; fa.x = __uint_as_float(a.x << 16); fa.y = __uint_as_float(a.x & 0xffff0000u); fa.z = __uint_as_float(a.y << 16); fa.w = __uint_as_float(a.y & 0xffff0000u);
            fb.x = __uint_as_float(bq.x << 16); fb.y = __uint_as_float(bq.x & 0xffff0000u); fb.z = __uint_as_float(bq.y << 16); fb.w = __uint_as_float(bq.y & 0xffff0000u);
            const f32x4 g2 = *(const f32x4*)(md + 5120 + col);
            v[j] = *(const f32x4*)(F.H + (size_t)row * D + col) + g2 * (fa * w0 + fb * w1); }
        if (!final) {
#pragma unroll
            for (int j = 0; j < 4; ++j) *(f32x4*)(F.H + (size_t)row * D + 4 * F.lane + 256 * j) = v[j];
            const float* md1 = F.mod + ((layer + 1) * 3 + mi) * 6144;
            norm_mod_store(v, F.gmix + (layer + 1) * D, md1 + 1024, md1, F.XN + (size_t)row * D, F.lane, t);
        } else {
            float s = 0.f;
#pragma unroll
            for (int j = 0; j < 4; ++j) s += (v[j].x * v[j].x + v[j].y * v[j].y) + (v[j].z * v[j].z + v[j].w * v[j].w);
            const float rstd = 1.f / sqrtf(wave_sum(s) * (1.f / D) + EPS);
#pragma unroll
            for (int j = 0; j < 4; ++j) { const int col = 4 * F.lane + 256 * j; *(f32x4*)(F.out + (size_t)row * D + col) = v[j] * rstd * *(const f32x4*)(F.final_g + col); }
        }
    }
}

__device__ __forceinline__ void unpack8(const v4u w, float (&f)[8]) {
    f[0] = __uint_as_float(w.x << 16); f[1] = __uint_as_float(w.x & 0xffff0000u); f[2] = __uint_as_float(w.y << 16); f[3] = __uint_as_float(w.y & 0xffff0000u);
    f[4] = __uint_as_float(w.z << 16); f[5] = __uint_as_float(w.z & 0xffff0000u); f[6] = __uint_as_float(w.w << 16); f[7] = __uint_as_float(w.w & 0xffff0000u);
}
typedef __bf16 bf16x2_t __attribute__((ext_vector_type(2)));
__device__ __forceinline__ unsigned cvtpk(float lo, float hi) { f32x2 v = {lo, hi}; return __builtin_bit_cast(unsigned, __builtin_convertvector(v, bf16x2_t)); }
#define NAT_THR 8.0f
__device__ __forceinline__ void natten_task(Frame& F, int b, int h, int r, const LAS float* rpbL) {
    const int lane = F.lane, q = lane & 15, fq = lane >> 4;
    const int rs = (r - 4) < 0 ? 0 : ((r - 4) > NROWS - 8 ? NROWS - 8 : (r - 4));
    const size_t qrow0 = (size_t)b * SEQ + (size_t)r * GRIDW;
    bf16x8 Qf[4][2];
#pragma unroll
    for (int qb = 0; qb < 4; ++qb)
#pragma unroll
        for (int dh = 0; dh < 2; ++dh) Qf[qb][dh] = *(const bf16x8*)(F.P + (qrow0 + 16 * qb + q) * P1LD + 1536 + 64 * h + 32 * dh + 8 * fq);
    f32x4 OT[4][4]; float mrun[4], lrun[4]; int cbase[4], bbase[4];
#pragma unroll
    for (int qb = 0; qb < 4; ++qb) { const int c = 16 * qb + q; const int cs = (c - 8) < 0 ? 0 : ((c - 8) > GRIDW - 16 ? GRIDW - 16 : (c - 8));
        cbase[qb] = 4 * fq - cs; bbase[qb] = 4 * fq - c + 15; mrun[qb] = -INFINITY; lrun[qb] = 0.f;
#pragma unroll
        for (int db = 0; db < 4; ++db) OT[qb][db] = (f32x4){0.f, 0.f, 0.f, 0.f}; }
    const bf16* kbase = F.P + 2048 + 64 * h + 8 * fq;
    const bf16* vbase = F.VT + (size_t)(64 * h + q) * MALL + 4 * fq;
    for (int kk = 0; kk < 8; ++kk) {
        const int kr = rs + kk; const size_t krow0 = (size_t)b * SEQ + (size_t)kr * GRIDW;
        const LAS float* brow = rpbL + (h * 15 + (kr - r + 7)) * 31;
        bf16x8 Kf[4][2];
#pragma unroll
        for (int kb = 0; kb < 4; ++kb)
#pragma unroll
            for (int dh = 0; dh < 2; ++dh) Kf[kb][dh] = *(const bf16x8*)(kbase + (krow0 + 16 * kb + q) * P1LD + 32 * dh);
        f32x4 S[4][4];
#pragma unroll
        for (int qb = 0; qb < 4; ++qb) {
            constexpr int KB0[4] = {0, 0, 1, 2}, KB1[4] = {2, 3, 4, 4};
            float ml = -INFINITY;
#pragma unroll
            for (int kb = 0; kb < 4; ++kb) if (kb >= KB0[qb] && kb < KB1[qb]) {
                f32x4 a = __builtin_amdgcn_mfma_f32_16x16x32_bf16(Kf[kb][0], Qf[qb][0], (f32x4){0.f, 0.f, 0.f, 0.f}, 0, 0, 0);
                a = __builtin_amdgcn_mfma_f32_16x16x32_bf16(Kf[kb][1], Qf[qb][1], a, 0, 0, 0);
#pragma unroll
                for (int j = 0; j < 4; ++j) { const bool valid = (unsigned)(cbase[qb] + 16 * kb + j) < 16u; const float bias = brow[bbase[qb] + 16 * kb + j];
                    a[j] = valid ? a[j] + bias : -INFINITY; ml = fmaxf(ml, a[j]); }
                S[qb][kb] = a;
            }
            ml = fmaxf(ml, __shfl_xor(ml, 16)); ml = fmaxf(ml, __shfl_xor(ml, 32));
            if (__any(ml > mrun[qb] + NAT_THR)) { const float mn = fmaxf(mrun[qb], ml), al = __builtin_amdgcn_exp2f(mrun[qb] - mn); mrun[qb] = mn; lrun[qb] *= al;
#pragma unroll
                for (int db = 0; db < 4; ++db) OT[qb][db] = OT[qb][db] * al; }
            float ls = 0.f;
#pragma unroll
            for (int kb = 0; kb < 4; ++kb) if (kb >= KB0[qb] && kb < KB1[qb]) {
#pragma unroll
                for (int j = 0; j < 4; ++j) { const float p = __builtin_amdgcn_exp2f(S[qb][kb][j] - mrun[qb]); S[qb][kb][j] = p; ls += p; } }
            else S[qb][kb] = (f32x4){0.f, 0.f, 0.f, 0.f};
            lrun[qb] += ls;
        }
#pragma unroll
        for (int g = 0; g < 2; ++g) {
            bf16x8 Vf[4];
#pragma unroll
            for (int db = 0; db < 4; ++db) { const bf16* vp = vbase + (size_t)(16 * db) * MALL + krow0 + 32 * g; const v2u lo = *(const v2u*)vp, hi = *(const v2u*)(vp + 16);
                Vf[db] = __builtin_bit_cast(bf16x8, (v4u){lo.x, lo.y, hi.x, hi.y}); }
#pragma unroll
            for (int qb = 0; qb < 4; ++qb) {
                constexpr int GOK[4][2] = {{1, 0}, {1, 1}, {1, 1}, {0, 1}};
                if (GOK[qb][g]) {
                    const f32x4 s0 = S[qb][2 * g], s1 = S[qb][2 * g + 1];
                    const bf16x8 pt = __builtin_bit_cast(bf16x8, (v4u){cvtpk(s0[0], s0[1]), cvtpk(s0[2], s0[3]), cvtpk(s1[0], s1[1]), cvtpk(s1[2], s1[3])});
#pragma unroll
                    for (int db = 0; db < 4; ++db) OT[qb][db] = __builtin_amdgcn_mfma_f32_16x16x32_bf16(Vf[db], pt, OT[qb][db], 0, 0, 0);
                }
            }
        }
    }
    for (int g = 0; g < 8; ++g) {
        const size_t ct0 = (size_t)MLAT + (size_t)b * CTXL + 32 * g;
        bf16x8 Kf[2][2];
#pragma unroll
        for (int kb = 0; kb < 2; ++kb)
#pragma unroll
            for (int dh = 0; dh < 2; ++dh) Kf[kb][dh] = *(const bf16x8*)(kbase + (ct0 + 16 * kb + q) * P1LD + 32 * dh);
        bf16x8 Vf[4];
#pragma unroll
        for (int db = 0; db < 4; ++db) { const bf16* vp = vbase + (size_t)(16 * db) * MALL + ct0; const v2u lo = *(const v2u*)vp, hi = *(const v2u*)(vp + 16);
            Vf[db] = __builtin_bit_cast(bf16x8, (v4u){lo.x, lo.y, hi.x, hi.y}); }
#pragma unroll
        for (int qb = 0; qb < 4; ++qb) {
            f32x4 s0 = __builtin_amdgcn_mfma_f32_16x16x32_bf16(Kf[0][0], Qf[qb][0], (f32x4){0.f, 0.f, 0.f, 0.f}, 0, 0, 0);
            s0 = __builtin_amdgcn_mfma_f32_16x16x32_bf16(Kf[0][1], Qf[qb][1], s0, 0, 0, 0);
            f32x4 s1 = __builtin_amdgcn_mfma_f32_16x16x32_bf16(Kf[1][0], Qf[qb][0], (f32x4){0.f, 0.f, 0.f, 0.f}, 0, 0, 0);
            s1 = __builtin_amdgcn_mfma_f32_16x16x32_bf16(Kf[1][1], Qf[qb][1], s1, 0, 0, 0);
            float ml = fmaxf(fmaxf(fmaxf(s0[0], s0[1]), fmaxf(s0[2], s0[3])), fmaxf(fmaxf(s1[0], s1[1]), fmaxf(s1[2], s1[3])));
            ml = fmaxf(ml, __shfl_xor(ml, 16)); ml = fmaxf(ml, __shfl_xor(ml, 32));
            if (__any(ml > mrun[qb] + NAT_THR)) { const float mn = fmaxf(mrun[qb], ml), al = __builtin_amdgcn_exp2f(mrun[qb] - mn); mrun[qb] = mn; lrun[qb] *= al;
#pragma unroll
                for (int db = 0; db < 4; ++db) OT[qb][db] = OT[qb][db] * al; }
            float ls = 0.f;
#pragma unroll
            for (int j = 0; j < 4; ++j) { s0[j] = __builtin_amdgcn_exp2f(s0[j] - mrun[qb]); s1[j] = __builtin_amdgcn_exp2f(s1[j] - mrun[qb]); ls += s0[j] + s1[j]; }
            lrun[qb] += ls;
            const bf16x8 pt = __builtin_bit_cast(bf16x8, (v4u){cvtpk(s0[0], s0[1]), cvtpk(s0[2], s0[3]), cvtpk(s1[0], s1[1]), cvtpk(s1[2], s1[3])});
#pragma unroll
            for (int db = 0; db < 4; ++db) OT[qb][db] = __builtin_amdgcn_mfma_f32_16x16x32_bf16(Vf[db], pt, OT[qb][db], 0, 0, 0);
        }
    }
#pragma unroll
    for (int qb = 0; qb < 4; ++qb) { float l = lrun[qb]; l += __shfl_xor(l, 16); l += __shfl_xor(l, 32); const float il = 1.f / l;
        bf16* op = F.XN + (qrow0 + 16 * qb + q) * D + 512 + 64 * h + 4 * fq;
#pragma unroll
        for (int db = 0; db < 4; ++db) { const f32x4 o = OT[qb][db] * il; v2u w; w.x = cvtpk(o[0], o[1]); w.y = cvtpk(o[2], o[3]); *(v2u*)(op + 16 * db) = w; } }
}
__device__ __forceinline__ void natten_phase(Frame& F) {
    LAS float* rpbL = (LAS float*)(F.lds + 1024);
    for (int i = F.tid; i < 8 * 15 * 31; i += NWAVES * 64) rpbL[i] = F.d_rpb[i] * 1.4426950408889634f;
    __syncthreads();
    for (int t = F.vcu; t < 256; t += F.G) natten_task(F, t >> 7, (t >> 4) & 7, (t & 15) * 8 + F.wave, rpbL);
    const int gw = F.vcu * NWAVES + F.wave, NGW = F.G * NWAVES;
    for (int qi = gw; qi < MLAT; qi += NGW) {
        const int b = qi >> 13, tt = qi & 8191;
        const int ch0 = 8 * F.lane; float accv[8];
#pragma unroll
        for (int d = 0; d < 8; ++d) accv[d] = 0.f;
#pragma unroll
        for (int k = 0; k < 3; ++k) { const int t2 = tt + k - 1;
            if (t2 >= 0 && t2 < SEQ) { float xi[8], cg[8]; const bf16* p = F.P + ((size_t)b * SEQ + t2) * P1LD + ch0; unpack8(*(const v4u*)p, xi); unpack8(*(const v4u*)(p + 1024), cg);
#pragma unroll
                for (int d = 0; d < 8; ++d) accv[d] += F.c_conv_w[k * 512 + ch0 + d] * (cg[d] * xi[d]); } }
        float bgv[8]; unpack8(*(const v4u*)(F.P + (size_t)qi * P1LD + 512 + ch0), bgv);
        v4u w2; w2.x = pk2(bgv[0] * accv[0], bgv[1] * accv[1]); w2.y = pk2(bgv[2] * accv[2], bgv[3] * accv[3]); w2.z = pk2(bgv[4] * accv[4], bgv[5] * accv[5]); w2.w = pk2(bgv[6] * accv[6], bgv[7] * accv[7]);
        *(v4u*)(F.XN + (size_t)qi * D + ch0) = w2;
    }
}

struct Args { const float* in[28]; float* out; unsigned char* ws; int ph_lo, ph_hi; };
__global__ void __launch_bounds__(NWAVES * 64, 2) hybrid_fwd(Args args) {
    extern __shared__ __attribute__((aligned(16))) unsigned char lds[];
    Frame F;
    F.lds = (LAS unsigned char*)lds;
    F.MISC = (volatile LAS unsigned*)(F.lds + MISC_OFF);
    F.tid = threadIdx.x; F.lane = F.tid & 63; F.wave = __builtin_amdgcn_readfirstlane(F.tid >> 6);
    F.G = gridDim.x; { const int bx = blockIdx.x; F.vcu = (F.G % 8 == 0) ? (bx % 8) * (F.G / 8) + bx / 8 : bx; }
    unsigned char* ws = args.ws;
    F.ctl = (gu32*)(ws + WS_CTL);
    F.x = args.in[0]; F.c = args.in[1]; F.ctx = args.in[2]; F.c_ctx = args.in[3]; F.ada_w = args.in[4]; F.ada_b = args.in[5]; F.gmix = args.in[6]; F.gffn = args.in[7];
    F.w_out = args.in[8]; F.ab_w_in = args.in[9]; F.a_dw_w = args.in[10]; F.a_dw_b = args.in[11]; F.a_ln_g = args.in[12]; F.a_ln_b = args.in[13]; F.b_conv_w = args.in[14]; F.b_conv_b = args.in[15];
    F.b_gate_w = args.in[16]; F.b_gate_b = args.in[17]; F.b_lambda = args.in[18]; F.cd_w_in = args.in[19]; F.c_conv_w = args.in[20]; F.d_rpb = args.in[21]; F.router_w = args.in[22]; F.router_bias = args.in[23];
    F.moe_wg = args.in[24]; F.moe_wu = args.in[25]; F.moe_wd = args.in[26]; F.final_g = args.in[27]; F.out = args.out;
    F.mod = (float*)(ws + WS_MOD); F.sum = (float*)(ws + WS_SUM); F.list = (int*)(ws + WS_LIST); F.rslot = (int*)(ws + WS_RSLOT); F.rw = (float*)(ws + WS_RW);
    F.Wab = (bf16*)(ws + WS_WAB); F.Wout = (bf16*)(ws + WS_WOUT); F.Wcd = (bf16*)(ws + WS_WCD); F.Wgu = (bf16*)(ws + WS_WGU); F.Wd = (bf16*)(ws + WS_WD); F.WgT = (bf16*)(ws + WS_GATEW);
    F.XN = (bf16*)(ws + WS_XN); F.P = (bf16*)(ws + WS_P); F.Y = (bf16*)(ws + WS_Y); F.HID = (bf16*)(ws + WS_HID); F.VT = (bf16*)(ws + WS_VT); F.H = (float*)(ws + WS_H);
    for (int u = F.tid; u < (LDS_BYTES - LDSCTL_OFF) / 4; u += NWAVES * 64) ((LAS unsigned*)(F.lds + LDSCTL_OFF))[u] = 0u;
    __syncthreads();
    XcdBarrier bar; bar.bar = (unsigned*)(F.ctl + CW_BAR); bar.x = 0; bar.st = nullptr;
    const int lo = args.ph_lo, hi = args.ph_hi;
    const bool multi = (hi - lo) > 1;
    if (multi) bar = xcd_barrier_post((unsigned*)(F.ctl + CW_BAR), F.MISC + 8);
#define IN(k) (lo <= (k) && (k) < hi)
#define SEAM(k) do { if (IN(k) && IN((k) + 1)) xcd_barrier(bar); } while (0)
    const int bx = (int)blockIdx.x;

    if (IN(0)) { p0_prologue(F); } SEAM(0);
    if (IN(1)) { p1_norm0(F); } SEAM(1);
    if (IN(2)) {
        pg8::SchedPlain S; S.so.init(MALL / 256, 2048 / 256, F.G, bx); S.A = (const char*)F.XN; S.B = (const char*)F.Wab; S.tstep = (size_t)256 * 1024 * 2;
        pg8::EpiBf16 E{F.P, 2048};
        pg8::gemm_phase<pg8::EpiBf16, pg8::SchedPlain, true, true>(F.lds, 1024, S, E);
    } SEAM(2);
    if (IN(3)) {
        for (int u = F.vcu; u < MALL / 32; u += F.G) conf_unit(F, u);
        lru_phase(F, false);
    } SEAM(3);
    if (IN(4)) { lru_phase(F, true); } SEAM(4);
    if (IN(5)) {
        pg8::SchedPlain S; S.so.init(MALL / 256, 4, F.G, bx); S.A = (const char*)F.XN; S.B = (const char*)F.Wout; S.tstep = (size_t)256 * 1024 * 2;
        pg8::EpiRes E{F.x, F.H, F.H, F.mod + 0 * 3 * 6144 + 2048};
        pg8::gemm_phase<pg8::EpiRes, pg8::SchedPlain, true, true>(F.lds, 1024, S, E);
    } SEAM(5);
    if (IN(6)) { route_phase(F, 0, MALL); } SEAM(6);
    if (IN(7)) {
        LAS int* ts = build_tiles(F, 0);
        pg8::SchedMoeGU S; S.so.init(__builtin_amdgcn_readfirstlane(ts[16]), 4, F.G, bx); S.ts = ts; S.A = (const char*)F.XN; S.B = (const char*)F.Wgu; S.list = F.list;
        pg8::EpiGateUp E{F.HID};
        pg8::gemm_phase<pg8::EpiGateUp, pg8::SchedMoeGU, true, true>(F.lds, 1024, S, E);
    } SEAM(7);
    if (IN(8)) {
        LAS int* ts = build_tiles(F, 0);
        pg8::SchedMoeDown S; S.so.init(__builtin_amdgcn_readfirstlane(ts[16]), 4, F.G, bx); S.ts = ts; S.A = (const char*)F.HID; S.B = (const char*)F.Wd;
        pg8::EpiBf16 E{F.Y, 1024};
        pg8::gemm_phase<pg8::EpiBf16, pg8::SchedMoeDown, true, true>(F.lds, 512, S, E);
    } SEAM(8);
    if (IN(9)) { combine_phase(F, 0, MALL, false); } SEAM(9);
    if (IN(10)) {
        pg8::SchedInproj1 S; S.so.init(64, 10, F.G, bx); S.X = (const char*)F.XN; S.W = (const char*)F.Wcd; S.G = F.G; S.c = bx;
        pg8::EpiInproj1 E{F.P, F.VT};
        pg8::gemm_phase<pg8::EpiInproj1, pg8::SchedInproj1, true, true>(F.lds, 1024, S, E);
    } SEAM(10);
    if (IN(11)) { natten_phase(F); } SEAM(11);
    if (IN(12)) {
        pg8::SchedPlain S; S.so.init(MLAT / 256, 4, F.G, bx); S.A = (const char*)F.XN; S.B = (const char*)(F.Wout + (size_t)1024 * 1024); S.tstep = (size_t)256 * 1024 * 2;
        pg8::EpiRes E{F.H, F.H, F.H, F.mod + 1 * 3 * 6144 + 2048};
        pg8::gemm_phase<pg8::EpiRes, pg8::SchedPlain, true, true>(F.lds, 1024, S, E);
    } SEAM(12);
    if (IN(13)) { route_phase(F, 1, MLAT); } SEAM(13);
    if (IN(14)) {
        LAS int* ts = build_tiles(F, 1);
        pg8::SchedMoeGU S; S.so.init(__builtin_amdgcn_readfirstlane(ts[16]), 4, F.G, bx); S.ts = ts; S.A = (const char*)F.XN; S.B = (const char*)(F.Wgu + (size_t)16 * 1024 * 1024); S.list = F.list + (size_t)16 * CAP;
        pg8::EpiGateUp E{F.HID};
        pg8::gemm_phase<pg8::EpiGateUp, pg8::SchedMoeGU, true, true>(F.lds, 1024, S, E);
    } SEAM(14);
    if (IN(15)) {
        LAS int* ts = build_tiles(F, 1);
        pg8::SchedMoeDown S; S.so.init(__builtin_amdgcn_readfirstlane(ts[16]), 4, F.G, bx); S.ts = ts; S.A = (const char*)F.HID; S.B = (const char*)(F.Wd + (size_t)16 * 1024 * 512);
        pg8::EpiBf16 E{F.Y, 1024};
        pg8::gemm_phase<pg8::EpiBf16, pg8::SchedMoeDown, true, true>(F.lds, 512, S, E);
    } SEAM(15);
    if (IN(16)) { combine_phase(F, 1, MLAT, true); }
#undef IN
#undef SEAM
}

extern "C" void kernel_launch(void* const* d_in, const int* in_sizes, int n_in, void* d_out, int out_size, void* d_ws, size_t ws_size, hipStream_t stream) {
    static int grid = 0;
    if (grid == 0) {
        if (n_in != 28 || in_sizes[0] != MLAT * D || out_size != MLAT * D || ws_size < WS_END) {
            fprintf(stderr, "kernel_launch: unexpected shapes / workspace (n_in %d, in0 %d, out %d, ws %zu < %zu); nothing launched\n", n_in, n_in > 0 ? in_sizes[0] : -1, out_size, ws_size, (size_t)WS_END); grid = -1; return; }
        int dev = 0, cus = 0, per_cu = 0;
        if (hipGetDevice(&dev) != hipSuccess || hipDeviceGetAttribute(&cus, hipDeviceAttributeMultiprocessorCount, dev) != hipSuccess) { grid = -1; return; }
        if (hipFuncSetAttribute((const void*)hybrid_fwd, hipFuncAttributeMaxDynamicSharedMemorySize, LDS_BYTES) != hipSuccess) { fprintf(stderr, "kernel_launch: hipFuncSetAttribute failed\n"); grid = -1; return; }
        if (hipOccupancyMaxActiveBlocksPerMultiprocessor(&per_cu, (const void*)hybrid_fwd, NWAVES * 64, LDS_BYTES) != hipSuccess || per_cu < 1) { fprintf(stderr, "kernel_launch: occupancy query reports %d\n", per_cu); per_cu = 1; }
        (void)hipGetLastError();
        grid = cus;
        if (grid != 256) fprintf(stderr, "kernel_launch: %d CUs\n", grid);
    }
    if (grid < 0) return;
    if (hipMemsetAsync((char*)d_ws + WS_CTL, 0, CTL_ZERO_BYTES, stream) != hipSuccess) return;
    Args a{};
    for (int i = 0; i < 28; ++i) a.in[i] = (const float*)d_in[i];
    a.out = (float*)d_out; a.ws = (unsigned char*)d_ws;
    if (MK_N_LAUNCHES == 1) { a.ph_lo = 0; a.ph_hi = NPH; hipLaunchKernelGGL(hybrid_fwd, dim3(grid), dim3(NWAVES * 64), LDS_BYTES, stream, a); }
    else for (int p = 0; p < NPH; ++p) { a.ph_lo = p; a.ph_hi = p + 1; hipLaunchKernelGGL(hybrid_fwd, dim3(grid), dim3(NWAVES * 64), LDS_BYTES, stream, a); }
}
```

```cpp
#include <hip/hip_runtime.h>
#include <cstdio>
#include <cstdint>

#ifndef MK_N_LAUNCHES
#define MK_N_LAUNCHES 1
#endif

#ifndef PROBE_PHASE
#define PROBE_PHASE -1
#endif
#define PROBE_REPS 4
#ifndef PROBE_SUB
#define PROBE_SUB 0
#endif
#ifndef DUPMASK
#define DUPMASK 0
#endif
#define NREP(k) (1 + ((DUPMASK >> (k)) & 1))
#define LAS __attribute__((address_space(3)))
#define GAS __attribute__((address_space(1)))
typedef unsigned short bf16;
typedef unsigned v4u __attribute__((ext_vector_type(4)));
typedef unsigned v2u __attribute__((ext_vector_type(2)));
typedef float f32x4 __attribute__((ext_vector_type(4)));
typedef float f32x2 __attribute__((ext_vector_type(2)));
typedef short bf16x8 __attribute__((ext_vector_type(8)));

constexpr int D = 1024, NBATCH = 2, SEQ = 8192, CTXL = 256;
constexpr int MLAT = NBATCH * SEQ;
constexpr int MCTX = NBATCH * CTXL;
constexpr int MALL = MLAT + MCTX;
constexpr int NEXP = 16, DFF = 512, CAP = MALL;
constexpr int GRIDW = 64, NROWS = SEQ / GRIDW;
constexpr float EPS = 1e-6f;
constexpr int NPH = 17;

constexpr size_t MiB = 1u << 20;
constexpr size_t WS_CTL = 0, CTL_ZERO_BYTES = 1 * MiB;
constexpr size_t WS_MOD = 1 * MiB;
constexpr size_t WS_SUM = 2 * MiB;
constexpr size_t WS_LIST = 5 * MiB;
constexpr size_t WS_RSLOT = 8 * MiB;
constexpr size_t WS_RW = 8 * MiB + 512 * 1024;
constexpr size_t WS_GATEW = 9 * MiB;
constexpr size_t WS_WAB = 10 * MiB;
constexpr size_t WS_WOUT = 14 * MiB;
constexpr size_t WS_WCD = 18 * MiB;
constexpr size_t WS_WGU = 24 * MiB;
constexpr size_t WS_WD = 88 * MiB;
constexpr size_t WS_XN = 120 * MiB;
constexpr size_t WS_H = 153 * MiB;
constexpr size_t WS_P = 219 * MiB;
constexpr int YROWS = 37632;
constexpr int P1LD = 2560;
constexpr size_t WS_VT = WS_P + (size_t)MALL * P1LD * 2;
constexpr float QSCALE = 0.125f * 1.4426950408889634f;
constexpr size_t WS_Y = WS_P, WS_HID = WS_P + (size_t)YROWS * 1024 * 2;
constexpr size_t WS_END = 330 * MiB;
static_assert(WS_HID + (size_t)YROWS * 512 * 2 <= WS_END, "ws map");
static_assert(WS_VT + (size_t)512 * MALL * 2 <= WS_END, "ws map");
constexpr int CW_BAR = 4096;
constexpr int CW_CNT = 16384;

constexpr int RING_BYTES = 131072;
constexpr int LDSCTL_OFF = RING_BYTES, MISC_OFF = LDSCTL_OFF + 320, TS_OFF = LDSCTL_OFF + 1024;
constexpr int LDS_BYTES = 147456;
constexpr int NWAVES = 8;

__device__ __forceinline__ float bf2f(bf16 b) { return __uint_as_float((unsigned)b << 16); }
__device__ __forceinline__ unsigned f2bf(float f) { unsigned u = __builtin_bit_cast(unsigned, f); return (u + 0x7fffu + ((u >> 16) & 1u)) >> 16; }
__device__ __forceinline__ unsigned pk2(float lo, float hi) { return f2bf(lo) | (f2bf(hi) << 16); }
__device__ __forceinline__ float sigm(float x) { return __builtin_amdgcn_rcpf(1.f + __builtin_amdgcn_exp2f(-1.4426950408889634f * x)); }
__device__ __forceinline__ float gelu_tanh(float x) { const float u = 0.7978845608028654f * (x + 0.044715f * x * x * x); return x * sigm(2.f * u); }
__device__ __forceinline__ float wave_sum(float v) {
#pragma unroll
    for (int o = 1; o < 64; o <<= 1) v += __shfl_xor(v, o);
    return v;
}
#define LDS_WAIT() asm volatile("s_waitcnt lgkmcnt(0)" ::: "memory")
#define RLX_AGENT __ATOMIC_RELAXED, __HIP_MEMORY_SCOPE_AGENT

namespace pg8 {
typedef unsigned short bf16_t;
typedef unsigned u32x4 __attribute__((ext_vector_type(4)));
constexpr int BM = 256, BK = 64, HALF = 128, HTB = HALF * BK * 2, STAGE_BYTES = 8 * HTB, NXCD = 8, WGM = 8;
__host__ __device__ __forceinline__ int lds_byte(int r, int c) { const int st = (r >> 4) * 2 + (c >> 5), rr = r & 15, cc = c & 31, ob = rr * 64 + cc * 2; return st * 1024 + (ob ^ (((ob >> 9) & 1) << 5)); }
__host__ __device__ __forceinline__ void stage_rc(int b, int& R, int& C) { const int st = b / 1024, sb = b % 1024, swz = sb ^ (((sb >> 9) & 1) << 5); R = (st >> 1) * 16 + swz / 64; C = (st & 1) * 32 + (swz % 64) / 2; }
__host__ __device__ __forceinline__ int perm32(int rho) { const int n = rho >> 4, i = rho & 15; return 8 * (i >> 2) + 4 * n + (i & 3); }

struct Unit { int pm, pn, e, r0, cnt; };

struct StaticOrder {
    int nM, nN, nwg, G, c;
    __device__ void init(int nM_, int nN_, int G_, int c_) { nM = nM_; nN = nN_; nwg = nM * nN; G = G_; c = c_; }
    __device__ bool next(int i, Unit& u) const {
        const long L = (long)i * G + c; if (L >= nwg) return false;
        int wgid = (int)L; { const int q = nwg / NXCD, r = nwg % NXCD, xcd = wgid % NXCD, off = wgid / NXCD; wgid = (xcd < r ? xcd * (q + 1) : r * (q + 1) + (xcd - r) * q) + off; }
        const int nig = WGM * nN, gid = wgid / nig, fm = gid * WGM, gsz = (nM - fm) < WGM ? (nM - fm) : WGM;
        u.pm = fm + ((wgid % nig) % gsz); u.pn = (wgid % nig) / gsz; u.e = 0; u.r0 = 0; u.cnt = 0; return true;
    }
};
struct SchedPlain {
    static constexpr bool GATHER = false;
    StaticOrder so; const char* A; const char* B; size_t tstep;
    __device__ __forceinline__ bool next(int i, Unit& u) const { return so.next(i, u); }
    __device__ __forceinline__ const char* a_ptr(const Unit& u) const { return A + (size_t)u.pm * tstep; }
    __device__ __forceinline__ const char* b_ptr(const Unit& u) const { return B + (size_t)u.pn * tstep; }
    __device__ __forceinline__ void a_offs(const Unit&, const int (&)[2], const int (&)[2], int, unsigned (&)[2][2]) const {}
};
struct SchedMoe {
    StaticOrder so; const LAS int* ts;
    __device__ __forceinline__ bool next(int i, Unit& u) const {
        if (!so.next(i, u)) return false;
        int e = 0;
#pragma unroll
        for (int j = 1; j < 16; ++j) e += (ts[j] <= u.pm) ? 1 : 0;
        e = __builtin_amdgcn_readfirstlane(e);
        u.e = e; u.r0 = (u.pm - __builtin_amdgcn_readfirstlane(ts[e])) * 256; u.cnt = __builtin_amdgcn_readfirstlane(ts[17 + e]); return true;
    }
};
struct SchedMoeGU : SchedMoe {
    static constexpr bool GATHER = true;
    const char* A; const char* B; const int* list;
    __device__ __forceinline__ const char* a_ptr(const Unit&) const { return A; }
    __device__ __forceinline__ const char* b_ptr(const Unit& u) const { return B + (size_t)u.e * (1024 * 1024 * 2) + (size_t)u.pn * (256 * 1024 * 2); }
    __device__ __forceinline__ void a_offs(const Unit& u, const int (&R)[2], const int (&C)[2], int K, unsigned (&v)[2][2]) const {
#pragma unroll
        for (int h = 0; h < 2; ++h)
#pragma unroll
            for (int i = 0; i < 2; ++i) { const int row = u.r0 + h * HALF + R[i]; int tok = 0; if (row < u.cnt) tok = list[u.e * CAP + row]; v[h][i] = (unsigned)(tok * K + C[i]) * 2u; }
    }
};
struct SchedMoeDown : SchedMoe {
    static constexpr bool GATHER = false;
    const char* A; const char* B;
    __device__ __forceinline__ const char* a_ptr(const Unit& u) const { return A + (size_t)u.pm * (256 * 512 * 2); }
    __device__ __forceinline__ const char* b_ptr(const Unit& u) const { return B + (size_t)u.e * (1024 * 512 * 2) + (size_t)u.pn * (256 * 512 * 2); }
    __device__ __forceinline__ void a_offs(const Unit&, const int (&)[2], const int (&)[2], int, unsigned (&)[2][2]) const {}
};

__device__ __forceinline__ unsigned cvt_pk_bf16(float lo, float hi) { unsigned r; asm volatile("v_cvt_pk_bf16_f32 %0, %1, %2" : "=v"(r) : "v"(lo), "v"(hi)); return r; }
struct EpiBf16 {
    static constexpr bool PERM = true;
    bf16_t* O; int ldc;
    __device__ __forceinline__ void operator()(const f32x4 (&acc)[2][2][4][2], const Unit& u, int wr, int wc, int fr, int fq) const {
        const int row0 = u.pm * BM + wr * 64 + fr, col0 = u.pn * BM + wc * 32 + 8 * fq;
#pragma unroll
        for (int ai = 0; ai < 2; ++ai)
#pragma unroll
            for (int m = 0; m < 4; ++m) { bf16_t* rowp = O + (size_t)(row0 + ai * HALF + m * 16) * ldc + col0;
#pragma unroll
                for (int bj = 0; bj < 2; ++bj) { const f32x4 v0 = acc[ai][bj][m][0], v1 = acc[ai][bj][m][1];
                    u32x4 w; w.x = cvt_pk_bf16(v0[0], v0[1]); w.y = cvt_pk_bf16(v0[2], v0[3]); w.z = cvt_pk_bf16(v1[0], v1[1]); w.w = cvt_pk_bf16(v1[2], v1[3]);
                    *(u32x4*)(rowp + bj * HALF) = w; } }
    }
};
struct EpiRes {
    static constexpr bool PERM = false;
    const float* hin_lat; const float* hin_ctx; float* hout; const float* gate;
    __device__ __forceinline__ void operator()(const f32x4 (&acc)[2][2][4][2], const Unit& u, int wr, int wc, int fr, int fq) const {
        const int row0 = u.pm * BM + wr * 64 + fr, col0 = u.pn * BM + wc * 32 + 4 * fq;
        const int mi = (u.pm >> 5) > 2 ? 2 : (u.pm >> 5);
        const float* src = (u.pm < 64) ? hin_lat : hin_ctx - (size_t)MLAT * D;
        f32x4 gv[2][2];
#pragma unroll
        for (int bj = 0; bj < 2; ++bj)
#pragma unroll
            for (int n = 0; n < 2; ++n) gv[bj][n] = *(const f32x4*)(gate + mi * 6144 + col0 + bj * HALF + n * 16);
#pragma unroll
        for (int ai = 0; ai < 2; ++ai)
#pragma unroll
            for (int m = 0; m < 4; ++m) { const size_t off = (size_t)(row0 + ai * HALF + m * 16) * D + col0;
#pragma unroll
                for (int bj = 0; bj < 2; ++bj)
#pragma unroll
                    for (int n = 0; n < 2; ++n) { const f32x4 b = *(const f32x4*)(src + off + bj * HALF + n * 16); *(f32x4*)(hout + off + bj * HALF + n * 16) = b + gv[bj][n] * acc[ai][bj][m][n]; } }
    }
};
struct EpiGateUp {
    static constexpr bool PERM = true;
    bf16_t* Hd;
    __device__ __forceinline__ void operator()(const f32x4 (&acc)[2][2][4][2], const Unit& u, int wr, int wc, int fr, int fq) const {
        const int row0 = u.pm * BM + wr * 64 + fr, col0 = u.pn * HALF + wc * 32 + 8 * fq;
#pragma unroll
        for (int ai = 0; ai < 2; ++ai)
#pragma unroll
            for (int m = 0; m < 4; ++m) { bf16_t* rowp = Hd + (size_t)(row0 + ai * HALF + m * 16) * DFF + col0;
                float h[8];
#pragma unroll
                for (int n = 0; n < 2; ++n)
#pragma unroll
                    for (int j = 0; j < 4; ++j) { const float g = acc[ai][0][m][n][j], up = acc[ai][1][m][n][j]; h[n * 4 + j] = g * sigm(g) * up; }
                u32x4 w; w.x = cvt_pk_bf16(h[0], h[1]); w.y = cvt_pk_bf16(h[2], h[3]); w.z = cvt_pk_bf16(h[4], h[5]); w.w = cvt_pk_bf16(h[6], h[7]);
                *(u32x4*)rowp = w; }
    }
};

struct SchedInproj1 {
    static constexpr bool GATHER = false;
    StaticOrder so; const char* X; const char* W; int G, c;
    __device__ __forceinline__ bool next(int i, Unit& u) const {
        const int L = i * G + c;
        if (L < 640) { return so.next(i, u); }
        if (L < 768) { const int idx = L - 640; u.pm = idx & 1; u.pn = idx >> 1; u.e = 1; u.r0 = 0; u.cnt = 0; return true; }
        if (L < 776) { const int idx = L - 768; if (idx < 4) { u.pm = 64 + (idx >> 1); u.pn = 8 + (idx & 1); u.e = 0; } else { u.pm = idx & 1; u.pn = 64 + ((idx >> 1) & 1); u.e = 1; } u.r0 = 0; u.cnt = 0; return true; }
        return false;
    }
    __device__ __forceinline__ const char* a_ptr(const Unit& u) const { return u.e ? W + (size_t)(10 + u.pm) * (256 * 1024 * 2) : X + (size_t)u.pm * (256 * 1024 * 2); }
    __device__ __forceinline__ const char* b_ptr(const Unit& u) const { return u.e ? X + (size_t)u.pn * (256 * 1024 * 2) : W + (size_t)u.pn * (256 * 1024 * 2); }
    __device__ __forceinline__ void a_offs(const Unit&, const int (&)[2], const int (&)[2], int, unsigned (&)[2][2]) const {}
};
struct EpiInproj1 {
    static constexpr bool PERM = true;
    bf16_t* P; bf16_t* VT;
    __device__ __forceinline__ void operator()(const f32x4 (&acc)[2][2][4][2], const Unit& u, int wr, int wc, int fr, int fq) const {
        const int row0 = u.pm * BM + wr * 64 + fr, col0 = u.pn * BM + wc * 32 + 8 * fq;
        bf16_t* O = u.e ? VT : P; const int ldc = u.e ? MALL : P1LD;
        const float sc = (!u.e && (u.pn == 6 || u.pn == 7)) ? QSCALE : 1.0f;
#pragma unroll
        for (int ai = 0; ai < 2; ++ai)
#pragma unroll
            for (int m = 0; m < 4; ++m) { bf16_t* rowp = O + (size_t)(row0 + ai * HALF + m * 16) * ldc + col0;
#pragma unroll
                for (int bj = 0; bj < 2; ++bj) { const f32x4 v0 = acc[ai][bj][m][0] * sc, v1 = acc[ai][bj][m][1] * sc;
                    u32x4 w; w.x = cvt_pk_bf16(v0[0], v0[1]); w.y = cvt_pk_bf16(v0[2], v0[3]); w.z = cvt_pk_bf16(v1[0], v1[1]); w.w = cvt_pk_bf16(v1[2], v1[3]);
                    *(u32x4*)(rowp + bj * HALF) = w; } }
    }
};

template <class Epi, class Sched, bool ALIGN_EPI, bool SP2>
__device__ __forceinline__ void gemm_phase(LAS unsigned char* lds, const int K, const Sched& S, const Epi& E) {
    const int tid = threadIdx.x, wid = __builtin_amdgcn_readfirstlane(tid >> 6), lane = tid & 63, wr = wid >> 2, wc = wid & 3, fr = lane & 15, fq = lane >> 4;
    const int nt = K / BK;
    const size_t kstep = (size_t)(BK * 2);
    const size_t hstep = (size_t)HALF * K * 2;
    int Rr[2], Cc[2]; unsigned voffB[2], vA[2][2], nvA[2][2];
#pragma unroll
    for (int i = 0; i < 2; ++i) { int R, C; stage_rc(tid * 16 + i * 8192, R, C); Rr[i] = R; Cc[i] = C; const int Rb = Epi::PERM ? ((R & ~31) + perm32(R & 31)) : R;
        voffB[i] = (unsigned)(Rb * K + C) * 2u; vA[0][i] = (unsigned)(R * K + C) * 2u; vA[1][i] = vA[0][i] + (unsigned)hstep; nvA[0][i] = vA[0][i]; nvA[1][i] = vA[1][i]; }
    const unsigned ldsw = (unsigned)wid * 1024u;
    const int aoff = lds_byte(wr * 64 + fr, fq * 8), boff = lds_byte(wc * 32 + fr, fq * 8);
#define PG8_SA(b, h) (((b) * 2 + (h)) * HTB)
#define PG8_SB(b, h) ((4 + (b) * 2 + (h)) * HTB)
#define PG8_STAGE(bufoff, gbase, voff) do { _Pragma("unroll") for (int _i = 0; _i < 2; ++_i) \
        __builtin_amdgcn_global_load_lds((const unsigned*)((const char*)(gbase) + (voff)[_i]), (LAS unsigned*)(lds + (bufoff) + ldsw + _i * 8192), 16, 0, 0); } while (0)
#define PG8_LDA(dst, b, h) do { _Pragma("unroll") for (int m = 0; m < 4; ++m) _Pragma("unroll") for (int k = 0; k < 2; ++k) dst[m][k] = *(const LAS bf16x8*)(lds + PG8_SA(b, h) + aoff + m * 2048 + k * 1024); } while (0)
#define PG8_LDB(dst, b, h) do { _Pragma("unroll") for (int n = 0; n < 2; ++n) _Pragma("unroll") for (int k = 0; k < 2; ++k) dst[n][k] = *(const LAS bf16x8*)(lds + PG8_SB(b, h) + boff + n * 2048 + k * 1024); } while (0)
#define PG8_MMA(ai, bj, At, Bt) do { __builtin_amdgcn_s_setprio(1); _Pragma("unroll") for (int m = 0; m < 4; ++m) _Pragma("unroll") for (int n = 0; n < 2; ++n) _Pragma("unroll") for (int k = 0; k < 2; ++k) \
        acc[ai][bj][m][n] = __builtin_amdgcn_mfma_f32_16x16x32_bf16(Bt[n][k], At[m][k], acc[ai][bj][m][n], 0, 0, 0); __builtin_amdgcn_s_setprio(0); } while (0)
#define PG8_WAIT_V(n) asm volatile("s_waitcnt vmcnt(" #n ")" ::: "memory")
#define PG8_WAIT_L(n) asm volatile("s_waitcnt lgkmcnt(" #n ")" ::: "memory")
#define PG8_BAR __builtin_amdgcn_s_barrier()
#define PG8_SCHED __builtin_amdgcn_sched_barrier(0)
    Unit cur, nxt; int ui = 0;
    if (!S.next(0, cur)) return;
    if constexpr (Sched::GATHER) { S.a_offs(cur, Rr, Cc, K, vA); }
    f32x4 acc[2][2][4][2];
#pragma unroll
    for (int a = 0; a < 2; ++a)
#pragma unroll
        for (int b = 0; b < 2; ++b)
#pragma unroll
            for (int m = 0; m < 4; ++m)
#pragma unroll
                for (int n = 0; n < 2; ++n) acc[a][b][m][n] = (f32x4){0.f, 0.f, 0.f, 0.f};
    bf16x8 At[4][2], B0[2][2], B1[2][2];
    const char* cA = S.a_ptr(cur); const char* cB = S.b_ptr(cur);
    static_assert(SP2, "only the two-super-phase loop is kept");
    PG8_STAGE(PG8_SB(0, 0), cB, voffB); PG8_STAGE(PG8_SB(0, 1), cB + hstep, voffB); PG8_STAGE(PG8_SA(0, 0), cA, vA[0]); PG8_STAGE(PG8_SA(0, 1), cA, vA[1]);
    if (wr == 1) PG8_BAR;
    PG8_WAIT_V(2); PG8_BAR;
    PG8_STAGE(PG8_SB(1, 0), cB + kstep, voffB); PG8_STAGE(PG8_SA(1, 0), cA + kstep, vA[0]); PG8_STAGE(PG8_SB(1, 1), cB + hstep + kstep, voffB);
    PG8_WAIT_V(6); PG8_BAR;
    for (;;) {
        const bool has_next = S.next(ui + 1, nxt);
        const char* nA = has_next ? S.a_ptr(nxt) : cA; const char* nB = has_next ? S.b_ptr(nxt) : cB;
        if constexpr (Sched::GATHER) { if (has_next) S.a_offs(nxt, Rr, Cc, K, nvA); }
        for (int t = 0; t < nt; t += 2) {
            const bool last = (t == nt - 2);
            const char* a1 = cA + (size_t)(t + 1) * kstep;
            const char* a2 = last ? nA : cA + (size_t)(t + 2) * kstep; const char* b2 = last ? nB : cB + (size_t)(t + 2) * kstep;
            const char* a3 = a2 + kstep; const char* b3 = b2 + kstep;
            unsigned wA[2][2];
#pragma unroll
            for (int h = 0; h < 2; ++h)
#pragma unroll
                for (int i = 0; i < 2; ++i) wA[h][i] = (Sched::GATHER && last) ? nvA[h][i] : vA[h][i];
            PG8_LDB(B0, 0, 0); PG8_LDB(B1, 0, 1); PG8_SCHED; PG8_LDA(At, 0, 0); PG8_STAGE(PG8_SA(1, 1), a1, vA[1]);
            PG8_WAIT_V(8); PG8_WAIT_L(0); PG8_BAR; PG8_MMA(0, 0, At, B0); PG8_MMA(0, 1, At, B1); PG8_BAR; PG8_SCHED;
            PG8_LDA(At, 0, 1); PG8_STAGE(PG8_SB(0, 0), b2, voffB); PG8_STAGE(PG8_SB(0, 1), b2 + hstep, voffB); PG8_STAGE(PG8_SA(0, 0), a2, wA[0]);
            PG8_WAIT_V(8); PG8_WAIT_L(0); PG8_BAR; PG8_MMA(1, 0, At, B0); PG8_MMA(1, 1, At, B1); PG8_BAR; PG8_SCHED;
            PG8_LDB(B0, 1, 0); PG8_LDB(B1, 1, 1); PG8_SCHED; PG8_LDA(At, 1, 0); PG8_STAGE(PG8_SA(0, 1), a2, wA[1]);
            PG8_WAIT_V(8); PG8_WAIT_L(0); PG8_BAR; PG8_MMA(0, 0, At, B0); PG8_MMA(0, 1, At, B1); PG8_BAR; PG8_SCHED;
            PG8_LDA(At, 1, 1); PG8_STAGE(PG8_SB(1, 0), b3, voffB); PG8_STAGE(PG8_SB(1, 1), b3 + hstep, voffB); PG8_STAGE(PG8_SA(1, 0), a3, wA[0]);
            PG8_WAIT_V(8); PG8_WAIT_L(0); PG8_BAR; PG8_MMA(1, 0, At, B0); PG8_MMA(1, 1, At, B1); PG8_BAR; PG8_SCHED;
        }
        if constexpr (ALIGN_EPI) { if (wr == 0) PG8_BAR; }
        E(acc, cur, wr, wc, fr, fq);
        if (!has_next) break;
#pragma unroll
        for (int a = 0; a < 2; ++a)
#pragma unroll
            for (int b = 0; b < 2; ++b)
#pragma unroll
                for (int m = 0; m < 4; ++m)
#pragma unroll
                    for (int n = 0; n < 2; ++n) acc[a][b][m][n] = (f32x4){0.f, 0.f, 0.f, 0.f};
        cur = nxt; cA = nA; cB = nB; ++ui;
        if constexpr (Sched::GATHER) {
#pragma unroll
            for (int h = 0; h < 2; ++h)
#pragma unroll
                for (int i = 0; i < 2; ++i) vA[h][i] = nvA[h][i];
        }
        if constexpr (ALIGN_EPI) { if (wr == 1) PG8_BAR; }
    }
    PG8_WAIT_V(0);
    if constexpr (!ALIGN_EPI) { if (wr == 0) PG8_BAR; }
    PG8_BAR;
#undef PG8_SA
#undef PG8_SB
#undef PG8_STAGE
#undef PG8_LDA
#undef PG8_LDB
#undef PG8_MMA
#undef PG8_WAIT_V
#undef PG8_WAIT_L
#undef PG8_BAR
#undef PG8_SCHED
}
}

typedef GAS unsigned gu32;
#define XB_TMO      128
#define XB_XCNT(j)  (256  + 64 * (j))
#define XB_XSUB(j)  (1280 + 64 * (j))
#define XB_XGEN(j)  (2304 + 64 * (j))
#define XB_TOP      3328
#define XB_TOPGEN   3392
#define XCD_BAR_WORDS 3456
#define XB_SPIN_CAP (1u << 20)
__device__ __forceinline__ unsigned xb_ld(unsigned* p)              { return __hip_atomic_load(p, __ATOMIC_RELAXED, __HIP_MEMORY_SCOPE_AGENT); }
__device__ __forceinline__ unsigned xb_add(unsigned* p, unsigned v) { return __hip_atomic_fetch_add(p, v, __ATOMIC_RELAXED, __HIP_MEMORY_SCOPE_AGENT); }
__device__ __forceinline__ unsigned xb_xcc_id() { return (unsigned)__builtin_amdgcn_s_getreg((3 << 11) | 20) & 0xFu; }
#define XB_SPIN(cond, bar) do { unsigned _sp = 0; while (cond) { __builtin_amdgcn_s_sleep(1); \
    if ((++_sp & 255u) == 0u) { if (xb_ld(&(bar)[XB_TMO])) break; if (_sp > XB_SPIN_CAP) { atomicAdd(&(bar)[XB_TMO], 1u); break; } } } } while (0)
struct XcdBarrier { unsigned* bar; unsigned x; volatile LAS unsigned* st; };
__device__ __forceinline__ XcdBarrier xcd_barrier_post(unsigned* bar, volatile LAS unsigned* st) {
    XcdBarrier b; b.bar = bar; b.x = xb_xcc_id(); b.st = st;
    if (threadIdx.x == 0) (void)xb_add(&bar[XB_XCNT(b.x)], 1u);
    return b;
}
__device__ __forceinline__ void xcd_barrier_complete(unsigned* bar, unsigned x, unsigned& nloc, unsigned& nx) {
    const unsigned G = gridDim.x * gridDim.y * gridDim.z;
    unsigned sum, cnt, mine, sp = 0u;
    for (;;) {
        sum = 0u; cnt = 0u; mine = 0u;
#pragma unroll
        for (unsigned j = 0; j < 16; ++j) { const unsigned c = xb_ld(&bar[XB_XCNT(j)]); sum += c; cnt += (c > 0u) ? 1u : 0u; mine = (j == x) ? c : mine; }
        if (sum == G) break;
        __builtin_amdgcn_s_sleep(1);
        if ((++sp & 255u) == 0u) { if (xb_ld(&bar[XB_TMO])) break; if (sp > XB_SPIN_CAP) { atomicAdd(&bar[XB_TMO], 1u); break; } }
    }
    nloc = mine > 0u ? mine : 1u; nx = cnt > 0u ? cnt : 1u;
}
__device__ __forceinline__ void xcd_barrier(const XcdBarrier& b) {
    asm volatile("s_waitcnt vmcnt(0)" ::: "memory");
    __syncthreads();
    if (threadIdx.x == 0) {
        unsigned* bar = b.bar;
        __builtin_amdgcn_s_waitcnt(0);
        unsigned nloc = b.st[0], nx = b.st[1];
        if (nloc == 0u) { xcd_barrier_complete(bar, b.x, nloc, nx); b.st[0] = nloc; b.st[1] = nx; }
        const unsigned old = xb_add(&bar[XB_XSUB(b.x)], 1u);
        const unsigned gen = old / nloc;
        if (old + 1u == (gen + 1u) * nloc) {
            __builtin_amdgcn_fence(__ATOMIC_RELEASE, "agent");
            asm volatile("s_waitcnt vmcnt(0)" ::: "memory");
            const unsigned og = xb_add(&bar[XB_TOP], 1u);
            const unsigned tg = og / nx;
            if (og + 1u == (tg + 1u) * nx) xb_add(&bar[XB_TOPGEN], 1u);
            else XB_SPIN(xb_ld(&bar[XB_TOPGEN]) == tg, bar);
            __builtin_amdgcn_fence(__ATOMIC_ACQUIRE, "agent");
            xb_add(&bar[XB_XGEN(b.x)], 1u);
            asm volatile("s_waitcnt vmcnt(0)" ::: "memory");
        } else {
            XB_SPIN(xb_ld(&bar[XB_XGEN(b.x)]) == gen, bar);
            __builtin_amdgcn_fence(__ATOMIC_ACQUIRE, "agent");
            asm volatile("s_waitcnt vmcnt(0)" ::: "memory");
        }
    }
    __syncthreads();
}

struct Frame {
    LAS unsigned char* lds;
    volatile LAS unsigned* MISC;
    gu32* ctl;
    int tid, lane, wave, vcu, G;
    const float *x, *c, *ctx, *c_ctx, *ada_w, *ada_b, *gmix, *gffn, *w_out, *ab_w_in, *a_dw_w, *a_dw_b, *a_ln_g, *a_ln_b, *b_conv_w, *b_conv_b, *b_gate_w, *b_gate_b, *b_lambda,
        *cd_w_in, *c_conv_w, *d_rpb, *router_w, *router_bias, *moe_wg, *moe_wu, *moe_wd, *final_g;
    float* out;
    float* mod; float* sum; int* list; int* rslot; float* rw;
    bf16 *Wab, *Wout, *Wcd, *Wgu, *Wd, *WgT;
    bf16 *XN, *P, *Y, *HID, *VT; float* H;
};

__device__ __forceinline__ void p0_transpose_item(const float* W, int K, int N, bf16* WT, int rbase, int rstride, LAS float* scr, int item, int lane) {
    const int nblk = N / 32, kb = item / nblk, nb = item % nblk, k0 = 64 * kb, n0 = 32 * nb;
    const int orow0 = rbase + (n0 >> 7) * rstride + (n0 & 127);
    { const int kr = lane >> 3, nq = lane & 7; f32x4 v[8];
#pragma unroll
      for (int i = 0; i < 8; ++i) v[i] = *(const f32x4*)(W + (size_t)(k0 + 8 * i + kr) * N + n0 + 4 * nq);
#pragma unroll
      for (int i = 0; i < 8; ++i) { LAS float* d = scr + (8 * i + kr) * 33 + 4 * nq; d[0] = v[i].x; d[1] = v[i].y; d[2] = v[i].z; d[3] = v[i].w; } }
    LDS_WAIT(); asm volatile("" ::: "memory");
    const int c = lane & 7;
#pragma unroll
    for (int j = 0; j < 4; ++j) { const int n = (lane >> 3) + 8 * j; const LAS float* s = scr + (8 * c) * 33 + n;
        v4u o; o.x = pk2(s[0 * 33], s[1 * 33]); o.y = pk2(s[2 * 33], s[3 * 33]); o.z = pk2(s[4 * 33], s[5 * 33]); o.w = pk2(s[6 * 33], s[7 * 33]);
        *(GAS v4u*)(WT + (size_t)(orow0 + n) * K + k0 + 8 * c) = o; }
    LDS_WAIT(); asm volatile("" ::: "memory");
}

__device__ __forceinline__ void p0_prologue(Frame& F) {
    LAS float* condL = (LAS float*)F.lds;
    LAS float* red = condL + 3 * 1024;
    for (int i = F.tid; i < 3072; i += NWAVES * 64) { const int m = i >> 10, k = i & 1023; const float cv = (m < 2) ? F.c[m * 1024 + k] : F.c_ctx[k]; condL[i] = cv * sigm(cv); }
    __syncthreads();
    if (blockIdx.x < 192) {
        const int cg = blockIdx.x, layer = cg / 96, col0 = (cg % 96) * 64;
        const float* W = F.ada_w + (size_t)layer * 1024 * 6144 + col0 + F.lane;
        const int k0 = F.wave * 128;
        float a0 = 0.f, a1 = 0.f, a2 = 0.f;
#pragma unroll 32
        for (int kk = 0; kk < 128; ++kk) { const int k = k0 + kk; const float w = W[(size_t)k * 6144]; a0 += condL[k] * w; a1 += condL[1024 + k] * w; a2 += condL[2048 + k] * w; }
        red[(F.wave * 3 + 0) * 64 + F.lane] = a0; red[(F.wave * 3 + 1) * 64 + F.lane] = a1; red[(F.wave * 3 + 2) * 64 + F.lane] = a2;
        __syncthreads();
        if (F.tid < 192) { const int m = F.tid >> 6, l = F.tid & 63; float s = 0.f;
#pragma unroll
            for (int w = 0; w < 8; ++w) s += red[(w * 3 + m) * 64 + l];
            F.mod[(layer * 3 + m) * 6144 + col0 + l] = s + F.ada_b[layer * 6144 + col0 + l]; }
    }
    __syncthreads();
    LAS float* scr = (LAS float*)(F.lds + F.wave * 16384);
    const int gw = F.vcu * NWAVES + F.wave, NGW = F.G * NWAVES;
    constexpr int I_AB = 16 * 64, I_OUT = 16 * 32, I_CD = 16 * 96, I_G = 16 * 16, I_DN = 8 * 32;
    constexpr int I_GW = 2 * 4;
    constexpr int NITEMS = 16 * I_GW + I_AB + 2 * I_OUT + I_CD + 32 * (2 * I_G + I_DN);
    for (int it = gw; it < NITEMS; it += NGW) {
        int r = it;
        if (r < 16 * I_GW) { const int blk = r / I_GW; p0_transpose_item(F.b_gate_w + (size_t)blk * 16384, 128, 128, F.WgT + (size_t)blk * 16384, 0, 128, scr, r % I_GW, F.lane); continue; } r -= 16 * I_GW;
        if (r < I_AB) { p0_transpose_item(F.ab_w_in, 1024, 2048, F.Wab, 0, 128, scr, r, F.lane); continue; } r -= I_AB;
        if (r < 2 * I_OUT) { const int l = r / I_OUT; p0_transpose_item(F.w_out + (size_t)l * 1024 * 1024, 1024, 1024, F.Wout + (size_t)l * 1024 * 1024, 0, 128, scr, r % I_OUT, F.lane); continue; } r -= 2 * I_OUT;
        if (r < I_CD) { p0_transpose_item(F.cd_w_in, 1024, 3072, F.Wcd, 0, 128, scr, r, F.lane); continue; } r -= I_CD;
        if (r < 32 * I_G) { const int le = r / I_G; p0_transpose_item(F.moe_wg + (size_t)le * 1024 * 512, 1024, 512, F.Wgu + (size_t)le * 1024 * 1024, 0, 256, scr, r % I_G, F.lane); continue; } r -= 32 * I_G;
        if (r < 32 * I_G) { const int le = r / I_G; p0_transpose_item(F.moe_wu + (size_t)le * 1024 * 512, 1024, 512, F.Wgu + (size_t)le * 1024 * 1024, 128, 256, scr, r % I_G, F.lane); continue; } r -= 32 * I_G;
        { const int le = r / I_DN; p0_transpose_item(F.moe_wd + (size_t)le * 512 * 1024, 512, 1024, F.Wd + (size_t)le * 1024 * 512, 0, 128, scr, r % I_DN, F.lane); }
    }
}

__device__ __forceinline__ void norm_mod_store(const f32x4 (&v)[4], const float* g, const float* sc, const float* sh, bf16* dst, int lane, f32x4 (&t)[4]) {
    float s = 0.f;
#pragma unroll
    for (int j = 0; j < 4; ++j) s += (v[j].x * v[j].x + v[j].y * v[j].y) + (v[j].z * v[j].z + v[j].w * v[j].w);
    const float rstd = 1.f / sqrtf(wave_sum(s) * (1.f / D) + EPS);
#pragma unroll
    for (int j = 0; j < 4; ++j) { const int col = 4 * lane + 256 * j;
        const f32x4 gg = *(const f32x4*)(g + col), ss = *(const f32x4*)(sc + col), hh = *(const f32x4*)(sh + col);
        t[j] = v[j] * rstd * gg * (ss + 1.0f) + hh;
        v2u o; o.x = pk2(t[j].x, t[j].y); o.y = pk2(t[j].z, t[j].w);
        *(v2u*)(dst + col) = o; }
}

__device__ __forceinline__ void p1_norm0(Frame& F) {
    const int gw = F.vcu * NWAVES + F.wave, NGW = F.G * NWAVES;
    for (int row = gw; row < MALL; row += NGW) {
        const float* src = (row < MLAT) ? F.x + (size_t)row * D : F.ctx + (size_t)(row - MLAT) * D;
        const int mi = (row >> 13) > 2 ? 2 : (row >> 13);
        f32x4 v[4], t[4];
#pragma unroll
        for (int j = 0; j < 4; ++j) v[j] = *(const f32x4*)(src + 4 * F.lane + 256 * j);
        const float* md = F.mod + (0 * 3 + mi) * 6144;
        norm_mod_store(v, F.gmix, md + 1024, md, F.XN + (size_t)row * D, F.lane, t);
    }
}

__device__ __forceinline__ void conf_unit(Frame& F, int u) {
    const int row0 = u * 32; int seq0, L;
    if (row0 < MLAT) { seq0 = (row0 >> 13) << 13; L = SEQ; } else { seq0 = MLAT + (((row0 - MLAT) >> 8) << 8); L = CTXL; }
    const int t0 = row0 - seq0, ch = F.tid;
    float uu[62];
    {
        const bf16* pb = F.P + (size_t)seq0 * 2048 + ch;
#pragma unroll
        for (int hb = 0; hb < 2; ++hb) {
            bf16 rv[31], rg[31];
#pragma unroll
            for (int i = 0; i < 31; ++i) { const int t = t0 - 15 + hb * 31 + i; const int tc = t < 0 ? 0 : (t >= L ? L - 1 : t); rv[i] = pb[(size_t)tc * 2048]; rg[i] = pb[(size_t)tc * 2048 + 512]; }
            __builtin_amdgcn_sched_barrier(0);
#pragma unroll
            for (int i = 0; i < 31; ++i) { const int t = t0 - 15 + hb * 31 + i; const bool ok = (t >= 0 && t < L); uu[hb * 31 + i] = ok ? bf2f(rv[i]) * sigm(bf2f(rg[i])) : 0.f; }
            __builtin_amdgcn_sched_barrier(0);
        }
    }
    float o[32]; const float bias = F.a_dw_b[ch];
#pragma unroll
    for (int t = 0; t < 32; ++t) o[t] = bias;
#pragma unroll
    for (int k = 0; k < 31; ++k) { const float w = F.a_dw_w[k * 512 + ch];
#pragma unroll
        for (int t = 0; t < 32; ++t) o[t] += w * uu[t + k]; }
    LAS float* red = (LAS float*)F.lds;
    LAS float* fin = red + 512;
    float mine = 0.f;
#pragma unroll
    for (int t = 0; t < 32; ++t) { const float s = wave_sum(o[t]), q = wave_sum(o[t] * o[t]); mine = (F.lane == t) ? s : mine; mine = (F.lane == 32 + t) ? q : mine; }
    red[F.wave * 64 + F.lane] = mine;
    __syncthreads();
    if (F.tid < 64) { float s = 0.f;
#pragma unroll
        for (int w = 0; w < 8; ++w) s += red[w * 64 + F.tid];
        fin[F.tid] = s; }
    __syncthreads();
    const float lg = F.a_ln_g[ch], lb = F.a_ln_b[ch];
#pragma unroll
    for (int t = 0; t < 32; ++t) { const float mean = fin[t] * (1.f / 512.f); float var = fin[32 + t] * (1.f / 512.f) - mean * mean; var = var < 0.f ? 0.f : var;
        const float y = (o[t] - mean) * (1.f / sqrtf(var + EPS)) * lg + lb;
        F.XN[(size_t)(row0 + t) * D + ch] = (bf16)f2bf(y * sigm(y)); }
    __syncthreads();
}

typedef float f32x16 __attribute__((ext_vector_type(16)));
constexpr int LRU_VSB = 0, LRU_PRE = 20480, LRU_SUB = LRU_PRE + 65536, LRU_CIN = LRU_SUB + 8192, LRU_CAR = LRU_CIN + 4096, LRU_TMP = LRU_CAR + 4096;
__device__ __forceinline__ void lru_carries(Frame& F, int b, int n, bool is_lat, int c0, int nch) {
    LAS float* car = (LAS float*)(F.lds + LRU_CAR);
    LAS float* tmp = (LAS float*)(F.lds + LRU_TMP);
    const int ch = F.tid & 127, dir = (F.tid >> 7) & 1, half = F.tid >> 8, cidx = 128 * n + ch;
    const int nlat_all = is_lat ? 128 : 0, nctx = is_lat ? 4 : 0;
    const int top = is_lat ? 127 : 3;
    const int nown = dir ? (top - (c0 + nch - 1)) : c0;
    const int Ltot = nctx + nown, mid = Ltot >> 1;
    const int i0 = half ? mid : 0, i1 = half ? Ltot : mid;
    const float* sb = F.sum + ((size_t)dir * 512 + cidx) * 2;
    float A = 1.f, B = 0.f;
    for (int ib = i0; ib < i1; ib += 8) {
        float As[8], Bs[8];
#pragma unroll
        for (int j = 0; j < 8; ++j) { int i = ib + j; i = i < i1 ? i : i1 - 1;
            int scn;
            if (i < nctx) scn = 4 * b + (dir ? 3 - i : i);
            else { const int k = i - nctx; const int cc = dir ? top - k : k; scn = is_lat ? 8 + 128 * b + cc : 4 * b + cc; }
            const float* p = sb + (size_t)scn * 2048; As[j] = p[0]; Bs[j] = p[1]; }
#pragma unroll
        for (int j = 0; j < 8; ++j) if (ib + j < i1) { B = As[j] * B + Bs[j]; A *= As[j]; }
    }
    if (half == 0) tmp[F.tid] = B;
    __syncthreads();
    if (half == 1) {
        float h = A * tmp[F.tid - 256] + B;
        if (dir == 0) { for (int i = 0; i < nch; ++i) { car[(i * 2 + 0) * 128 + ch] = h; const int scn = is_lat ? 8 + 128 * b + c0 + i : 4 * b + c0 + i; const float* p = sb + (size_t)scn * 2048; h = p[0] * h + p[1]; } }
        else { for (int i = nch - 1; i >= 0; --i) { car[(i * 2 + 1) * 128 + ch] = h; const int scn = is_lat ? 8 + 128 * b + c0 + i : 4 * b + c0 + i; const float* p = sb + (size_t)scn * 2048; h = p[0] * h + p[1]; } }
    }
    __syncthreads();
}
__device__ __forceinline__ void lru_chunk(Frame& F, int b, int n, bool is_lat, int c, int ci, bool final) {
    const int sc = is_lat ? 8 + 128 * b + c : 4 * b + c;
    const int seq0 = is_lat ? b * SEQ : MLAT + b * CTXL, L = is_lat ? SEQ : CTXL;
    const int t0 = c * 64, ch = F.tid & 127, tq = F.tid >> 7, cidx = 128 * n + ch;
    LAS bf16* vsb = (LAS bf16*)(F.lds + LRU_VSB);
    LAS float* pre = (LAS float*)(F.lds + LRU_PRE);
    LAS float* sub = (LAS float*)(F.lds + LRU_SUB);
    LAS float* cin = (LAS float*)(F.lds + LRU_CIN);
    const LAS float* car = (const LAS float*)(F.lds + LRU_CAR);
    float vown[16];
    {
        float uu[19];
#pragma unroll
        for (int tt = 0; tt < 19; ++tt) { const int t = t0 + tq * 16 + tt - 2; const int tc = t < 0 ? 0 : (t >= L ? L - 1 : t); const float val = bf2f(F.P[(size_t)(seq0 + tc) * 2048 + 1024 + cidx]); uu[tt] = (t == tc) ? val : 0.f; }
        const float w0 = F.b_conv_w[cidx], w1 = F.b_conv_w[512 + cidx], w2 = F.b_conv_w[1024 + cidx], w3 = F.b_conv_w[1536 + cidx], cb = F.b_conv_b[cidx];
#pragma unroll
        for (int t = 0; t < 16; ++t) { vown[t] = cb + w0 * uu[t] + w1 * uu[t + 1] + w2 * uu[t + 2] + w3 * uu[t + 3]; vsb[(tq * 16 + t) * 136 + ch] = (bf16)f2bf(vown[t]); }
    }
    __syncthreads();
    float acc[4][16];
    {
        const int g = F.wave & 1, th = (F.wave >> 1) & 1, chh = F.wave >> 2, l31 = F.lane & 31, hk = F.lane >> 5;
        bf16x8 Af[8];
#pragma unroll
        for (int ks = 0; ks < 8; ++ks) Af[ks] = *(const LAS bf16x8*)(vsb + (32 * th + l31) * 136 + 16 * ks + 8 * hk);
#pragma unroll
        for (int d = 0; d < 2; ++d) {
            const bf16* wt = F.WgT + ((size_t)((d * 2 + g) * 4 + n) * 128 + 64 * chh + l31) * 128 + 8 * hk;
#pragma unroll
            for (int cb = 0; cb < 2; ++cb) {
                f32x16 a16 = {0.f, 0.f, 0.f, 0.f, 0.f, 0.f, 0.f, 0.f, 0.f, 0.f, 0.f, 0.f, 0.f, 0.f, 0.f, 0.f};
#pragma unroll
                for (int ks = 0; ks < 8; ++ks) { const bf16x8 Bf = *(const bf16x8*)(wt + (size_t)(32 * cb) * 128 + 16 * ks); a16 = __builtin_amdgcn_mfma_f32_32x32x16_bf16(Af[ks], Bf, a16, 0, 0, 0); }
#pragma unroll
                for (int r = 0; r < 16; ++r) pre[(g * 64 + 32 * th + (r & 3) + 8 * (r >> 2) + 4 * hk) * 128 + 64 * chh + 32 * cb + l31] = a16[r];
            }
            __syncthreads();
            const float lam = F.b_lambda[d * 512 + cidx]; const float el = __expf(-lam); const float spd = (el < 0.05f) ? el * (1.f + el * (-0.5f + el * (0.33333333f - 0.25f * el))) : log1pf(el);
            const float br = F.b_gate_b[(d * 2 + 0) * 512 + cidx], bi = F.b_gate_b[(d * 2 + 1) * 512 + cidx];
#pragma unroll
            for (int t = 0; t < 16; ++t) { const float r = sigm(pre[(tq * 16 + t) * 128 + ch] + br), ii = sigm(pre[(64 + tq * 16 + t) * 128 + ch] + bi);
                const float la = -8.0f * r * spd; const float a = __expf(la); const float bm = __builtin_amdgcn_sqrtf(fmaxf(1.f - a * a, 0.f));
                acc[2 * d][t] = a; acc[2 * d + 1][t] = bm * ii * vown[t]; }
            __syncthreads();
        }
    }
    { float A = 1.f, B = 0.f;
#pragma unroll
        for (int t = 0; t < 16; ++t) { B = acc[0][t] * B + acc[1][t]; A *= acc[0][t]; }
        sub[((0 * 4 + tq) * 128 + ch) * 2] = A; sub[((0 * 4 + tq) * 128 + ch) * 2 + 1] = B;
        A = 1.f; B = 0.f;
#pragma unroll
        for (int t = 15; t >= 0; --t) { B = acc[2][t] * B + acc[3][t]; A *= acc[2][t]; }
        sub[((1 * 4 + tq) * 128 + ch) * 2] = A; sub[((1 * 4 + tq) * 128 + ch) * 2 + 1] = B; }
    __syncthreads();
    if (!final) {
        if (F.tid < 256) { const int dir = F.tid >> 7; float A = 1.f, B = 0.f;
#pragma unroll
            for (int s = 0; s < 4; ++s) { const int q = dir ? 3 - s : s; const float As = sub[((dir * 4 + q) * 128 + ch) * 2], Bs = sub[((dir * 4 + q) * 128 + ch) * 2 + 1]; B = As * B + Bs; A *= As; }
            float* dst = F.sum + ((size_t)(sc * 2 + dir) * 512 + cidx) * 2; dst[0] = A; dst[1] = B; }
        __syncthreads();
        return;
    }
    if (F.tid < 256) {
        const int dir = F.tid >> 7; float h = car[(ci * 2 + dir) * 128 + ch];
        if (dir == 0) {
#pragma unroll
            for (int q = 0; q < 4; ++q) { cin[(0 * 4 + q) * 128 + ch] = h; h = sub[((0 * 4 + q) * 128 + ch) * 2] * h + sub[((0 * 4 + q) * 128 + ch) * 2 + 1]; }
        } else {
#pragma unroll
            for (int q = 3; q >= 0; --q) { cin[(1 * 4 + q) * 128 + ch] = h; h = sub[((1 * 4 + q) * 128 + ch) * 2] * h + sub[((1 * 4 + q) * 128 + ch) * 2 + 1]; }
        }
    }
    __syncthreads();
    {
        float y[16]; float h = cin[(0 * 4 + tq) * 128 + ch];
#pragma unroll
        for (int t = 0; t < 16; ++t) { h = acc[0][t] * h + acc[1][t]; y[t] = h; }
        h = cin[(1 * 4 + tq) * 128 + ch];
#pragma unroll
        for (int t = 15; t >= 0; --t) { h = acc[2][t] * h + acc[3][t]; y[t] += h; }
#pragma unroll
        for (int t = 0; t < 16; ++t) { const size_t row = (size_t)(seq0 + t0 + tq * 16 + t); const float g = bf2f(F.P[row * 2048 + 1536 + cidx]);
            F.XN[row * D + 512 + cidx] = (bf16)f2bf(y[t] * gelu_tanh(g)); }
    }
    __syncthreads();
}
__device__ __forceinline__ void lru_phase(Frame& F, bool final) {
    for (int gi = F.vcu; gi < 256 + 32; gi += F.G) {
        if (gi < 256) { const int b = gi >> 7, n = (gi >> 5) & 3, c0 = (gi & 31) * 4;
            if (final) lru_carries(F, b, n, true, c0, 4);
            for (int i = 0; i < 4; ++i) lru_chunk(F, b, n, true, c0 + i, i, final);
        } else { const int k = gi - 256, b = k >> 4, n = (k >> 2) & 3, c = k & 3;
            if (final) lru_carries(F, b, n, false, c, 1);
            lru_chunk(F, b, n, false, c, 0, final);
        }
    }
}

__device__ __forceinline__ LAS int* build_tiles(Frame& F, int layer) {
    LAS int* ts = (LAS int*)(F.lds + TS_OFF);
    if (F.tid == 0) { int a = 0;
        for (int e = 0; e < 16; ++e) { const int c = (int)__hip_atomic_load(F.ctl + CW_CNT + layer * 64 + e, RLX_AGENT); ts[e] = a; ts[17 + e] = c; a += (c + 255) >> 8; }
        ts[16] = a; }
    __syncthreads();
    return ts;
}

__device__ __forceinline__ void route_phase(Frame& F, int layer, int nrows) {
    LAS float* RwT = (LAS float*)F.lds;
    LAS int* lcnt = (LAS int*)(F.lds + 65536);
    LAS int* lbase = lcnt + 16;
    LAS int* tabi = lbase + 16;
    LAS float* tabw = (LAS float*)(tabi + 512);
    for (int i = F.tid; i < 16384; i += NWAVES * 64) RwT[(i & 15) * 1024 + (i >> 4)] = F.router_w[i];
    if (F.tid < 16) lcnt[F.tid] = 0;
    __syncthreads();
    const int per = (nrows + F.G - 1) / F.G, tok0 = blockIdx.x * per;
    float rb[16];
#pragma unroll
    for (int e = 0; e < 16; ++e) rb[e] = F.router_bias[e];
    for (int ti = F.wave; ti < per; ti += NWAVES) {
        const int token = tok0 + ti; if (token >= nrows) break;
        const int mi = (token >> 13) > 2 ? 2 : (token >> 13);
        f32x4 v[4], t[4];
#pragma unroll
        for (int j = 0; j < 4; ++j) v[j] = *(const f32x4*)(F.H + (size_t)token * D + 4 * F.lane + 256 * j);
        const float* md = F.mod + (layer * 3 + mi) * 6144;
        norm_mod_store(v, F.gffn + layer * D, md + 4096, md + 3072, F.XN + (size_t)token * D, F.lane, t);
        float score[16], sel[16];
#pragma unroll
        for (int e = 0; e < 16; ++e) { float p = 0.f;
#pragma unroll
            for (int j = 0; j < 4; ++j) { const f32x4 w = *(const LAS f32x4*)(RwT + e * 1024 + 4 * F.lane + 256 * j); p += (t[j].x * w.x + t[j].y * w.y) + (t[j].z * w.z + t[j].w * w.w); }
            p = wave_sum(p); score[e] = 1.f / (1.f + expf(-p)); sel[e] = score[e] + rb[e]; }
        int bg = 0; float bgs = -INFINITY;
#pragma unroll
        for (int g = 0; g < 4; ++g) { const float a = sel[4 * g], bq = sel[4 * g + 1], cq = sel[4 * g + 2], dq = sel[4 * g + 3];
            const float gs = fmaxf(fmaxf(fmaxf(a + bq, a + cq), fmaxf(a + dq, bq + cq)), fmaxf(bq + dq, cq + dq));
            if (gs > bgs) { bgs = gs; bg = g; } }
        float s4[4], c4[4];
#pragma unroll
        for (int j = 0; j < 4; ++j) { s4[j] = sel[j]; c4[j] = score[j]; }
#pragma unroll
        for (int g = 1; g < 4; ++g)
#pragma unroll
            for (int j = 0; j < 4; ++j) { s4[j] = (bg == g) ? sel[4 * g + j] : s4[j]; c4[j] = (bg == g) ? score[4 * g + j] : c4[j]; }
        int i1 = 0; float v1 = s4[0], sc1 = c4[0];
#pragma unroll
        for (int j = 1; j < 4; ++j) if (s4[j] > v1) { v1 = s4[j]; i1 = j; sc1 = c4[j]; }
        int i2 = -1; float v2 = -INFINITY, sc2 = 0.f;
#pragma unroll
        for (int j = 0; j < 4; ++j) if (j != i1 && s4[j] > v2) { v2 = s4[j]; i2 = j; sc2 = c4[j]; }
        if (F.lane == 0) { const int e0 = 4 * bg + i1, e1 = 4 * bg + i2; const float inv = 1.f / (sc1 + sc2);
            const int p0 = __hip_atomic_fetch_add(lcnt + e0, 1, __ATOMIC_RELAXED, __HIP_MEMORY_SCOPE_WORKGROUP), p1 = __hip_atomic_fetch_add(lcnt + e1, 1, __ATOMIC_RELAXED, __HIP_MEMORY_SCOPE_WORKGROUP);
            tabi[ti * 4 + 0] = e0; tabi[ti * 4 + 1] = p0; tabi[ti * 4 + 2] = e1; tabi[ti * 4 + 3] = p1; tabw[ti * 2] = sc1 * inv; tabw[ti * 2 + 1] = sc2 * inv; }
    }
    __syncthreads();
    if (F.tid < 16) lbase[F.tid] = (int)__hip_atomic_fetch_add(F.ctl + CW_CNT + layer * 64 + F.tid, (unsigned)lcnt[F.tid], RLX_AGENT);
    __syncthreads();
    if (F.tid < per && tok0 + F.tid < nrows) { const int token = tok0 + F.tid;
#pragma unroll
        for (int k = 0; k < 2; ++k) { const int e = tabi[F.tid * 4 + 2 * k], idx = lbase[e] + tabi[F.tid * 4 + 2 * k + 1];
            F.list[(size_t)layer * 16 * CAP + e * CAP + idx] = token; F.rslot[((size_t)layer * MALL + token) * 2 + k] = e * CAP + idx; F.rw[((size_t)layer * MALL + token) * 2 + k] = tabw[F.tid * 2 + k]; } }
    __syncthreads();
}

__device__ __forceinline__ void combine_phase(Frame& F, int layer, int nrows, bool final) {
    LAS int* ts = build_tiles(F, layer);
    const int gw = F.vcu * NWAVES + F.wave, NGW = F.G * NWAVES;
    for (int row = gw; row < nrows; row += NGW) {
        const int mi = (row >> 13) > 2 ? 2 : (row >> 13);
        const int s0 = F.rslot[((size_t)layer * MALL + row) * 2], s1 = F.rslot[((size_t)layer * MALL + row) * 2 + 1];
        const float w0 = F.rw[((size_t)layer * MALL + row) * 2], w1 = F.rw[((size_t)layer * MALL + row) * 2 + 1];
        const int e0 = s0 / CAP, e1 = s1 / CAP;
        const size_t y0 = (size_t)(ts[e0] * 256 + (s0 - e0 * CAP)), y1 = (size_t)(ts[e1] * 256 + (s1 - e1 * CAP));
        const float* md = F.mod + (layer * 3 + mi) * 6144;
        f32x4 v[4], t[4];
#pragma unroll
        for (int j = 0; j < 4; ++j) { const int col = 4 * F.lane + 256 * j;
            const v2u a = *(const v2u*)(F.Y + y0 * D + col), bq = *(const v2u*)(F.Y + y1 * D + col);
            f32x4 fa, fb; fa.x = __uint_as_float(a.x << 16); fa.y = __uint_as_float(a.x & 0xffff0000u); fa.z = __uint_as_float(a.y << 16); fa.w = __uint_as_float(a.y & 0xffff0000u);
            fb.x = __uint_as_float(bq.x << 16); fb.y = __uint_as_float(bq.x & 0xffff0000u); fb.z = __uint_as_float(bq.y << 16); fb.w = __uint_as_float(bq.y & 0xffff0000u);
            const f32x4 g2 = *(const f32x4*)(md + 5120 + col);
            v[j] = *(const f32x4*)(F.H + (size_t)row * D + col) + g2 * (fa * w0 + fb * w1); }
        if (!final) {
#pragma unroll
            for (int j = 0; j < 4; ++j) *(f32x4*)(F.H + (size_t)row * D + 4 * F.lane + 256 * j) = v[j];
            const float* md1 = F.mod + ((layer + 1) * 3 + mi) * 6144;
            norm_mod_store(v, F.gmix + (layer + 1) * D, md1 + 1024, md1, F.XN + (size_t)row * D, F.lane, t);
        } else {
            float s = 0.f;
#pragma unroll
            for (int j = 0; j < 4; ++j) s += (v[j].x * v[j].x + v[j].y * v[j].y) + (v[j].z * v[j].z + v[j].w * v[j].w);
            const float rstd = 1.f / sqrtf(wave_sum(s) * (1.f / D) + EPS);
#pragma unroll
            for (int j = 0; j < 4; ++j) { const int col = 4 * F.lane + 256 * j; *(f32x4*)(F.out + (size_t)row * D + col) = v[j] * rstd * *(const f32x4*)(F.final_g + col); }
        }
    }
}

__device__ __forceinline__ void unpack8(const v4u w, float (&f)[8]) {
    f[0] = __uint_as_float(w.x << 16); f[1] = __uint_as_float(w.x & 0xffff0000u); f[2] = __uint_as_float(w.y << 16); f[3] = __uint_as_float(w.y & 0xffff0000u);
    f[4] = __uint_as_float(w.z << 16); f[5] = __uint_as_float(w.z & 0xffff0000u); f[6] = __uint_as_float(w.w << 16); f[7] = __uint_as_float(w.w & 0xffff0000u);
}
typedef __bf16 bf16x2_t __attribute__((ext_vector_type(2)));
__device__ __forceinline__ unsigned cvtpk(float lo, float hi) { f32x2 v = {lo, hi}; return __builtin_bit_cast(unsigned, __builtin_convertvector(v, bf16x2_t)); }
#define NAT_THR 8.0f
__device__ __forceinline__ void natten_task(Frame& F, int b, int h, int r, const LAS float* rpbL) {
    const int lane = F.lane, q = lane & 15, fq = lane >> 4;
    const int rs = (r - 4) < 0 ? 0 : ((r - 4) > NROWS - 8 ? NROWS - 8 : (r - 4));
    const size_t qrow0 = (size_t)b * SEQ + (size_t)r * GRIDW;
    bf16x8 Qf[4][2];
#pragma unroll
    for (int qb = 0; qb < 4; ++qb)
#pragma unroll
        for (int dh = 0; dh < 2; ++dh) Qf[qb][dh] = *(const bf16x8*)(F.P + (qrow0 + 16 * qb + q) * P1LD + 1536 + 64 * h + 32 * dh + 8 * fq);
    f32x4 OT[4][4]; float mrun[4], lrun[4]; int cbase[4], bbase[4];
#pragma unroll
    for (int qb = 0; qb < 4; ++qb) { const int c = 16 * qb + q; const int cs = (c - 8) < 0 ? 0 : ((c - 8) > GRIDW - 16 ? GRIDW - 16 : (c - 8));
        cbase[qb] = 4 * fq - cs; bbase[qb] = 4 * fq - c + 15; mrun[qb] = -INFINITY; lrun[qb] = 0.f;
#pragma unroll
        for (int db = 0; db < 4; ++db) OT[qb][db] = (f32x4){0.f, 0.f, 0.f, 0.f}; }
    const bf16* kbase = F.P + 2048 + 64 * h + 8 * fq;
    const bf16* vbase = F.VT + (size_t)(64 * h + q) * MALL + 4 * fq;
    for (int kk = 0; kk < 8; ++kk) {
        const int kr = rs + kk; const size_t krow0 = (size_t)b * SEQ + (size_t)kr * GRIDW;
        const LAS float* brow = rpbL + (h * 15 + (kr - r + 7)) * 31;
        bf16x8 Kf[4][2];
#pragma unroll
        for (int kb = 0; kb < 4; ++kb)
#pragma unroll
            for (int dh = 0; dh < 2; ++dh) Kf[kb][dh] = *(const bf16x8*)(kbase + (krow0 + 16 * kb + q) * P1LD + 32 * dh);
        f32x4 S[4][4];
#pragma unroll
        for (int qb = 0; qb < 4; ++qb) {
            constexpr int KB0[4] = {0, 0, 1, 2}, KB1[4] = {2, 3, 4, 4};
            float ml = -INFINITY;
#pragma unroll
            for (int kb = 0; kb < 4; ++kb) if (kb >= KB0[qb] && kb < KB1[qb]) {
                f32x4 a = __builtin_amdgcn_mfma_f32_16x16x32_bf16(Kf[kb][0], Qf[qb][0], (f32x4){0.f, 0.f, 0.f, 0.f}, 0, 0, 0);
                a = __builtin_amdgcn_mfma_f32_16x16x32_bf16(Kf[kb][1], Qf[qb][1], a, 0, 0, 0);
#pragma unroll
                for (int j = 0; j < 4; ++j) { const bool valid = (unsigned)(cbase[qb] + 16 * kb + j) < 16u; const float bias = brow[bbase[qb] + 16 * kb + j];
                    a[j] = valid ? a[j] + bias : -INFINITY; ml = fmaxf(ml, a[j]); }
                S[qb][kb] = a;
            }
            ml = fmaxf(ml, __shfl_xor(ml, 16)); ml = fmaxf(ml, __shfl_xor(ml, 32));
            if (__any(ml > mrun[qb] + NAT_THR)) { const float mn = fmaxf(mrun[qb], ml), al = __builtin_amdgcn_exp2f(mrun[qb] - mn); mrun[qb] = mn; lrun[qb] *= al;
#pragma unroll
                for (int db = 0; db < 4; ++db) OT[qb][db] = OT[qb][db] * al; }
            float ls = 0.f;
#pragma unroll
            for (int kb = 0; kb < 4; ++kb) if (kb >= KB0[qb] && kb < KB1[qb]) {
#pragma unroll
                for (int j = 0; j < 4; ++j) { const float p = __builtin_amdgcn_exp2f(S[qb][kb][j] - mrun[qb]); S[qb][kb][j] = p; ls += p; } }
            else S[qb][kb] = (f32x4){0.f, 0.f, 0.f, 0.f};
            lrun[qb] += ls;
        }
#pragma unroll
        for (int g = 0; g < 2; ++g) {
            bf16x8 Vf[4];
#pragma unroll
            for (int db = 0; db < 4; ++db) { const bf16* vp = vbase + (size_t)(16 * db) * MALL + krow0 + 32 * g; const v2u lo = *(const v2u*)vp, hi = *(const v2u*)(vp + 16);
                Vf[db] = __builtin_bit_cast(bf16x8, (v4u){lo.x, lo.y, hi.x, hi.y}); }
#pragma unroll
            for (int qb = 0; qb < 4; ++qb) {
                constexpr int GOK[4][2] = {{1, 0}, {1, 1}, {1, 1}, {0, 1}};
                if (GOK[qb][g]) {
                    const f32x4 s0 = S[qb][2 * g], s1 = S[qb][2 * g + 1];
                    const bf16x8 pt = __builtin_bit_cast(bf16x8, (v4u){cvtpk(s0[0], s0[1]), cvtpk(s0[2], s0[3]), cvtpk(s1[0], s1[1]), cvtpk(s1[2], s1[3])});
#pragma unroll
                    for (int db = 0; db < 4; ++db) OT[qb][db] = __builtin_amdgcn_mfma_f32_16x16x32_bf16(Vf[db], pt, OT[qb][db], 0, 0, 0);
                }
            }
        }
    }
    for (int g = 0; g < 8; ++g) {
        const size_t ct0 = (size_t)MLAT + (size_t)b * CTXL + 32 * g;
        bf16x8 Kf[2][2];
#pragma unroll
        for (int kb = 0; kb < 2; ++kb)
#pragma unroll
            for (int dh = 0; dh < 2; ++dh) Kf[kb][dh] = *(const bf16x8*)(kbase + (ct0 + 16 * kb + q) * P1LD + 32 * dh);
        bf16x8 Vf[4];
#pragma unroll
        for (int db = 0; db < 4; ++db) { const bf16* vp = vbase + (size_t)(16 * db) * MALL + ct0; const v2u lo = *(const v2u*)vp, hi = *(const v2u*)(vp + 16);
            Vf[db] = __builtin_bit_cast(bf16x8, (v4u){lo.x, lo.y, hi.x, hi.y}); }
#pragma unroll
        for (int qb = 0; qb < 4; ++qb) {
            f32x4 s0 = __builtin_amdgcn_mfma_f32_16x16x32_bf16(Kf[0][0], Qf[qb][0], (f32x4){0.f, 0.f, 0.f, 0.f}, 0, 0, 0);
            s0 = __builtin_amdgcn_mfma_f32_16x16x32_bf16(Kf[0][1], Qf[qb][1], s0, 0, 0, 0);
            f32x4 s1 = __builtin_amdgcn_mfma_f32_16x16x32_bf16(Kf[1][0], Qf[qb][0], (f32x4){0.f, 0.f, 0.f, 0.f}, 0, 0, 0);
            s1 = __builtin_amdgcn_mfma_f32_16x16x32_bf16(Kf[1][1], Qf[qb][1], s1, 0, 0, 0);
            float ml = fmaxf(fmaxf(fmaxf(s0[0], s0[1]), fmaxf(s0[2], s0[3])), fmaxf(fmaxf(s1[0], s1[1]), fmaxf(s1[2], s1[3])));
            ml = fmaxf(ml, __shfl_xor(ml, 16)); ml = fmaxf(ml, __shfl_xor(ml, 32));
            if (__any(ml > mrun[qb] + NAT_THR)) { const float mn = fmaxf(mrun[qb], ml), al = __builtin_amdgcn_exp2f(mrun[qb] - mn); mrun[qb] = mn; lrun[qb] *= al;
#pragma unroll
                for (int db = 0; db < 4; ++db) OT[qb][db] = OT[qb][db] * al; }
            float ls = 0.f;
#pragma unroll
            for (int j = 0; j < 4; ++j) { s0[j] = __builtin_amdgcn_exp2f(s0[j] - mrun[qb]); s1[j] = __builtin_amdgcn_exp2f(s1[j] - mrun[qb]); ls += s0[j] + s1[j]; }
            lrun[qb] += ls;
            const bf16x8 pt = __builtin_bit_cast(bf16x8, (v4u){cvtpk(s0[0], s0[1]), cvtpk(s0[2], s0[3]), cvtpk(s1[0], s1[1]), cvtpk(s1[2], s1[3])});
#pragma unroll
            for (int db = 0; db < 4; ++db) OT[qb][db] = __builtin_amdgcn_mfma_f32_16x16x32_bf16(Vf[db], pt, OT[qb][db], 0, 0, 0);
        }
    }
#pragma unroll
    for (int qb = 0; qb < 4; ++qb) { float l = lrun[qb]; l += __shfl_xor(l, 16); l += __shfl_xor(l, 32); const float il = 1.f / l;
        bf16* op = F.XN + (qrow0 + 16 * qb + q) * D + 512 + 64 * h + 4 * fq;
#pragma unroll
        for (int db = 0; db < 4; ++db) { const f32x4 o = OT[qb][db] * il; v2u w; w.x = cvtpk(o[0], o[1]); w.y = cvtpk(o[2], o[3]); *(v2u*)(op + 16 * db) = w; } }
}
__device__ __forceinline__ void natten_phase(Frame& F) {
    LAS float* rpbL = (LAS float*)(F.lds + 1024);
    for (int i = F.tid; i < 8 * 15 * 31; i += NWAVES * 64) rpbL[i] = F.d_rpb[i] * 1.4426950408889634f;
    __syncthreads();
    for (int t = F.vcu; t < 256; t += F.G) natten_task(F, t >> 7, (t >> 4) & 7, (t & 15) * 8 + F.wave, rpbL);
    const int gw = F.vcu * NWAVES + F.wave, NGW = F.G * NWAVES;
    for (int qi = gw; qi < MLAT; qi += NGW) {
        const int b = qi >> 13, tt = qi & 8191;
        const int ch0 = 8 * F.lane; float accv[8];
#pragma unroll
        for (int d = 0; d < 8; ++d) accv[d] = 0.f;
#pragma unroll
        for (int k = 0; k < 3; ++k) { const int t2 = tt + k - 1;
            const int t2c = t2 < 0 ? 0 : (t2 >= SEQ ? SEQ - 1 : t2); const float ok = (t2 == t2c) ? 1.f : 0.f;
            float xi[8], cg[8]; const bf16* p = F.P + ((size_t)b * SEQ + t2c) * P1LD + ch0; unpack8(*(const v4u*)p, xi); unpack8(*(const v4u*)(p + 1024), cg);
#pragma unroll
            for (int d = 0; d < 8; ++d) accv[d] += (ok * F.c_conv_w[k * 512 + ch0 + d]) * (cg[d] * xi[d]); }
        float bgv[8]; unpack8(*(const v4u*)(F.P + (size_t)qi * P1LD + 512 + ch0), bgv);
        v4u w2; w2.x = pk2(bgv[0] * accv[0], bgv[1] * accv[1]); w2.y = pk2(bgv[2] * accv[2], bgv[3] * accv[3]); w2.z = pk2(bgv[4] * accv[4], bgv[5] * accv[5]); w2.w = pk2(bgv[6] * accv[6], bgv[7] * accv[7]);
        *(v4u*)(F.XN + (size_t)qi * D + ch0) = w2;
    }
}

struct Args { const float* in[28]; float* out; unsigned char* ws; int ph_lo, ph_hi, sub, pad; };
__global__ void __launch_bounds__(NWAVES * 64, 2) hybrid_fwd(Args args) {
    extern __shared__ __attribute__((aligned(16))) unsigned char lds[];
    Frame F;
    F.lds = (LAS unsigned char*)lds;
    F.MISC = (volatile LAS unsigned*)(F.lds + MISC_OFF);
    F.tid = threadIdx.x; F.lane = F.tid & 63; F.wave = __builtin_amdgcn_readfirstlane(F.tid >> 6);
    F.G = gridDim.x; { const int bx = blockIdx.x; F.vcu = (F.G % 8 == 0) ? (bx % 8) * (F.G / 8) + bx / 8 : bx; }
    unsigned char* ws = args.ws;
    F.ctl = (gu32*)(ws + WS_CTL);
    F.x = args.in[0]; F.c = args.in[1]; F.ctx = args.in[2]; F.c_ctx = args.in[3]; F.ada_w = args.in[4]; F.ada_b = args.in[5]; F.gmix = args.in[6]; F.gffn = args.in[7];
    F.w_out = args.in[8]; F.ab_w_in = args.in[9]; F.a_dw_w = args.in[10]; F.a_dw_b = args.in[11]; F.a_ln_g = args.in[12]; F.a_ln_b = args.in[13]; F.b_conv_w = args.in[14]; F.b_conv_b = args.in[15];
    F.b_gate_w = args.in[16]; F.b_gate_b = args.in[17]; F.b_lambda = args.in[18]; F.cd_w_in = args.in[19]; F.c_conv_w = args.in[20]; F.d_rpb = args.in[21]; F.router_w = args.in[22]; F.router_bias = args.in[23];
    F.moe_wg = args.in[24]; F.moe_wu = args.in[25]; F.moe_wd = args.in[26]; F.final_g = args.in[27]; F.out = args.out;
    F.mod = (float*)(ws + WS_MOD); F.sum = (float*)(ws + WS_SUM); F.list = (int*)(ws + WS_LIST); F.rslot = (int*)(ws + WS_RSLOT); F.rw = (float*)(ws + WS_RW);
    F.Wab = (bf16*)(ws + WS_WAB); F.Wout = (bf16*)(ws + WS_WOUT); F.Wcd = (bf16*)(ws + WS_WCD); F.Wgu = (bf16*)(ws + WS_WGU); F.Wd = (bf16*)(ws + WS_WD); F.WgT = (bf16*)(ws + WS_GATEW);
    F.XN = (bf16*)(ws + WS_XN); F.P = (bf16*)(ws + WS_P); F.Y = (bf16*)(ws + WS_Y); F.HID = (bf16*)(ws + WS_HID); F.VT = (bf16*)(ws + WS_VT); F.H = (float*)(ws + WS_H);
    for (int u = F.tid; u < (LDS_BYTES - LDSCTL_OFF) / 4; u += NWAVES * 64) ((LAS unsigned*)(F.lds + LDSCTL_OFF))[u] = 0u;
    __syncthreads();
    XcdBarrier bar; bar.bar = (unsigned*)(F.ctl + CW_BAR); bar.x = 0; bar.st = nullptr;
    const int lo = args.ph_lo, hi = args.ph_hi;
    const bool multi = (hi - lo) > 1;
    if (multi) bar = xcd_barrier_post((unsigned*)(F.ctl + CW_BAR), F.MISC + 8);
#define IN(k) (lo <= (k) && (k) < hi)
#define SEAM(k) do { if (IN(k) && IN((k) + 1)) xcd_barrier(bar); } while (0)
    const int bx = (int)blockIdx.x;

    if (IN(0)) { for (int rep = 0; rep < NREP(0); ++rep) p0_prologue(F); } SEAM(0);
    if (IN(1)) { for (int rep = 0; rep < NREP(1); ++rep) p1_norm0(F); } SEAM(1);
    if (IN(2)) for (int rep = 0; rep < NREP(2); ++rep) {
        pg8::SchedPlain S; S.so.init(MALL / 256, 2048 / 256, F.G, bx); S.A = (const char*)F.XN; S.B = (const char*)F.Wab; S.tstep = (size_t)256 * 1024 * 2;
        pg8::EpiBf16 E{F.P, 2048};
        pg8::gemm_phase<pg8::EpiBf16, pg8::SchedPlain, true, true>(F.lds, 1024, S, E);
    } SEAM(2);
    if (IN(3)) for (int rep = 0; rep < NREP(3); ++rep) {
        if (args.sub != 2) for (int u = F.vcu; u < MALL / 32; u += F.G) conf_unit(F, u);
        if (args.sub != 1) lru_phase(F, false);
    } SEAM(3);
    if (IN(4)) { for (int rep = 0; rep < NREP(4); ++rep) lru_phase(F, true); } SEAM(4);
    if (IN(5)) {
        pg8::SchedPlain S; S.so.init(MALL / 256, 4, F.G, bx); S.A = (const char*)F.XN; S.B = (const char*)F.Wout; S.tstep = (size_t)256 * 1024 * 2;
        pg8::EpiRes E{F.x, F.ctx, F.H, F.mod + 0 * 3 * 6144 + 2048};
        pg8::gemm_phase<pg8::EpiRes, pg8::SchedPlain, true, true>(F.lds, 1024, S, E);
    } SEAM(5);
    if (IN(6)) { route_phase(F, 0, MALL); } SEAM(6);
    if (IN(7)) for (int rep = 0; rep < NREP(7); ++rep) {
        LAS int* ts = build_tiles(F, 0);
        pg8::SchedMoeGU S; S.so.init(__builtin_amdgcn_readfirstlane(ts[16]), 4, F.G, bx); S.ts = ts; S.A = (const char*)F.XN; S.B = (const char*)F.Wgu; S.list = F.list;
        pg8::EpiGateUp E{F.HID};
        pg8::gemm_phase<pg8::EpiGateUp, pg8::SchedMoeGU, true, true>(F.lds, 1024, S, E);
    } SEAM(7);
    if (IN(8)) for (int rep = 0; rep < NREP(8); ++rep) {
        LAS int* ts = build_tiles(F, 0);
        pg8::SchedMoeDown S; S.so.init(__builtin_amdgcn_readfirstlane(ts[16]), 4, F.G, bx); S.ts = ts; S.A = (const char*)F.HID; S.B = (const char*)F.Wd;
        pg8::EpiBf16 E{F.Y, 1024};
        pg8::gemm_phase<pg8::EpiBf16, pg8::SchedMoeDown, true, true>(F.lds, 512, S, E);
    } SEAM(8);
    if (IN(9)) { combine_phase(F, 0, MALL, false); } SEAM(9);
    if (IN(10)) for (int rep = 0; rep < NREP(10); ++rep) {
        pg8::SchedInproj1 S; S.so.init(64, 10, F.G, bx); S.X = (const char*)F.XN; S.W = (const char*)F.Wcd; S.G = F.G; S.c = bx;
        pg8::EpiInproj1 E{F.P, F.VT};
        pg8::gemm_phase<pg8::EpiInproj1, pg8::SchedInproj1, true, true>(F.lds, 1024, S, E);
    } SEAM(10);
    if (IN(11)) { for (int rep = 0; rep < NREP(11); ++rep) natten_phase(F); } SEAM(11);
    if (IN(12)) {
        pg8::SchedPlain S; S.so.init(MLAT / 256, 4, F.G, bx); S.A = (const char*)F.XN; S.B = (const char*)(F.Wout + (size_t)1024 * 1024); S.tstep = (size_t)256 * 1024 * 2;
        pg8::EpiRes E{F.H, F.H, F.H, F.mod + 1 * 3 * 6144 + 2048};
        pg8::gemm_phase<pg8::EpiRes, pg8::SchedPlain, true, true>(F.lds, 1024, S, E);
    } SEAM(12);
    if (IN(13)) { route_phase(F, 1, MLAT); } SEAM(13);
    if (IN(14)) for (int rep = 0; rep < NREP(14); ++rep) {
        LAS int* ts = build_tiles(F, 1);
        pg8::SchedMoeGU S; S.so.init(__builtin_amdgcn_readfirstlane(ts[16]), 4, F.G, bx); S.ts = ts; S.A = (const char*)F.XN; S.B = (const char*)(F.Wgu + (size_t)16 * 1024 * 1024); S.list = F.list + (size_t)16 * CAP;
        pg8::EpiGateUp E{F.HID};
        pg8::gemm_phase<pg8::EpiGateUp, pg8::SchedMoeGU, true, true>(F.lds, 1024, S, E);
    } SEAM(14);
    if (IN(15)) for (int rep = 0; rep < NREP(15); ++rep) {
        LAS int* ts = build_tiles(F, 1);
        pg8::SchedMoeDown S; S.so.init(__builtin_amdgcn_readfirstlane(ts[16]), 4, F.G, bx); S.ts = ts; S.A = (const char*)F.HID; S.B = (const char*)(F.Wd + (size_t)16 * 1024 * 512);
        pg8::EpiBf16 E{F.Y, 1024};
        pg8::gemm_phase<pg8::EpiBf16, pg8::SchedMoeDown, true, true>(F.lds, 512, S, E);
    } SEAM(15);
    if (IN(16)) { for (int rep = 0; rep < NREP(16); ++rep) combine_phase(F, 1, MLAT, true); }
#undef IN
#undef SEAM
}

extern "C" void kernel_launch(void* const* d_in, const int* in_sizes, int n_in, void* d_out, int out_size, void* d_ws, size_t ws_size, hipStream_t stream) {
    static int grid = 0;
    if (grid == 0) {
        if (n_in != 28 || in_sizes[0] != MLAT * D || out_size != MLAT * D || ws_size < WS_END) {
            fprintf(stderr, "kernel_launch: unexpected shapes / workspace (n_in %d, in0 %d, out %d, ws %zu < %zu); nothing launched\n", n_in, n_in > 0 ? in_sizes[0] : -1, out_size, ws_size, (size_t)WS_END); grid = -1; return; }
        int dev = 0, cus = 0, per_cu = 0;
        if (hipGetDevice(&dev) != hipSuccess || hipDeviceGetAttribute(&cus, hipDeviceAttributeMultiprocessorCount, dev) != hipSuccess) { grid = -1; return; }
        if (hipFuncSetAttribute((const void*)hybrid_fwd, hipFuncAttributeMaxDynamicSharedMemorySize, LDS_BYTES) != hipSuccess) { fprintf(stderr, "kernel_launch: hipFuncSetAttribute failed\n"); grid = -1; return; }
        if (hipOccupancyMaxActiveBlocksPerMultiprocessor(&per_cu, (const void*)hybrid_fwd, NWAVES * 64, LDS_BYTES) != hipSuccess || per_cu < 1) { fprintf(stderr, "kernel_launch: occupancy query reports %d\n", per_cu); per_cu = 1; }
        (void)hipGetLastError();
        grid = cus;
        if (grid != 256) fprintf(stderr, "kernel_launch: %d CUs\n", grid);
    }
    if (grid < 0) return;
    if (hipMemsetAsync((char*)d_ws + WS_CTL, 0, CTL_ZERO_BYTES, stream) != hipSuccess) return;
    Args a{};
    for (int i = 0; i < 28; ++i) a.in[i] = (const float*)d_in[i];
    a.out = (float*)d_out; a.ws = (unsigned char*)d_ws;
    if (MK_N_LAUNCHES == 1) { a.ph_lo = 0; a.ph_hi = NPH; hipLaunchKernelGGL(hybrid_fwd, dim3(grid), dim3(NWAVES * 64), LDS_BYTES, stream, a); }
    else for (int p = 0; p < NPH; ++p) { a.ph_lo = p; a.ph_hi = p + 1;
        const int reps = (p == PROBE_PHASE) ? 1 + PROBE_REPS : 1;
        for (int r = 0; r < reps; ++r) {
            a.sub = (r > 0) ? PROBE_SUB : 0;
            if (r > 0 && (p == 6 || p == 13)) (void)hipMemsetAsync((char*)d_ws + WS_CTL + (size_t)(CW_CNT + (p == 13 ? 64 : 0)) * 4, 0, 64, stream);
            hipLaunchKernelGGL(hybrid_fwd, dim3(grid), dim3(NWAVES * 64), LDS_BYTES, stream, a); } }
}
```

```cpp
#include <hip/hip_runtime.h>
#include <cstdio>
#include <cstdint>

#ifndef MK_N_LAUNCHES
#define MK_N_LAUNCHES 1
#endif

#ifndef PROBE_PHASE
#define PROBE_PHASE -1
#endif
#define PROBE_REPS 4
#ifndef PROBE_SUB
#define PROBE_SUB 0
#endif
#ifndef DUPMASK
#define DUPMASK 0
#endif
#define NREP(k) (1 + ((DUPMASK >> (k)) & 1))
#define LAS __attribute__((address_space(3)))
#define GAS __attribute__((address_space(1)))
typedef unsigned short bf16;
typedef unsigned v4u __attribute__((ext_vector_type(4)));
typedef unsigned v2u __attribute__((ext_vector_type(2)));
typedef float f32x4 __attribute__((ext_vector_type(4)));
typedef float f32x2 __attribute__((ext_vector_type(2)));
typedef short bf16x8 __attribute__((ext_vector_type(8)));

constexpr int D = 1024, NBATCH = 2, SEQ = 8192, CTXL = 256;
constexpr int MLAT = NBATCH * SEQ;
constexpr int MCTX = NBATCH * CTXL;
constexpr int MALL = MLAT + MCTX;
constexpr int NEXP = 16, DFF = 512, CAP = MALL;
constexpr int GRIDW = 64, NROWS = SEQ / GRIDW;
constexpr float EPS = 1e-6f;
constexpr int NPH = 17;

constexpr size_t MiB = 1u << 20;
constexpr size_t WS_CTL = 0, CTL_ZERO_BYTES = 1 * MiB;
constexpr size_t WS_MOD = 1 * MiB;
constexpr size_t WS_SUM = 2 * MiB;
constexpr size_t WS_LIST = 5 * MiB;
constexpr size_t WS_RSLOT = 8 * MiB;
constexpr size_t WS_RW = 8 * MiB + 512 * 1024;
constexpr size_t WS_GATEW = 9 * MiB;
constexpr size_t WS_WAB = 10 * MiB;
constexpr size_t WS_WOUT = 14 * MiB;
constexpr size_t WS_WCD = 18 * MiB;
constexpr size_t WS_WGU = 24 * MiB;
constexpr size_t WS_WD = 88 * MiB;
constexpr size_t WS_XN = 120 * MiB;
constexpr size_t WS_H = 153 * MiB;
constexpr size_t WS_P = 219 * MiB;
constexpr int YROWS = 37632;
constexpr int P1LD = 2560;
constexpr size_t WS_VT = WS_P + (size_t)MALL * P1LD * 2;
constexpr float QSCALE = 0.125f * 1.4426950408889634f;
constexpr size_t WS_Y = WS_P, WS_HID = WS_P + (size_t)YROWS * 1024 * 2;
constexpr size_t WS_END = 330 * MiB;
static_assert(WS_HID + (size_t)YROWS * 512 * 2 <= WS_END, "ws map");
static_assert(WS_VT + (size_t)512 * MALL * 2 <= WS_END, "ws map");
constexpr int CW_BAR = 4096;
constexpr int CW_CNT = 16384;

constexpr int RING_BYTES = 131072;
constexpr int SCR_BYTES = 143360;
constexpr int LDSCTL_OFF = SCR_BYTES, MISC_OFF = LDSCTL_OFF + 320, TS_OFF = LDSCTL_OFF + 1024;
constexpr int LDS_BYTES = 147456;
constexpr int NWAVES = 8;

__device__ __forceinline__ float bf2f(bf16 b) { return __uint_as_float((unsigned)b << 16); }
__device__ __forceinline__ unsigned f2bf(float f) { unsigned u = __builtin_bit_cast(unsigned, f); return (u + 0x7fffu + ((u >> 16) & 1u)) >> 16; }
__device__ __forceinline__ unsigned pk2(float lo, float hi) { return f2bf(lo) | (f2bf(hi) << 16); }
__device__ __forceinline__ float sigm(float x) { return __builtin_amdgcn_rcpf(1.f + __builtin_amdgcn_exp2f(-1.4426950408889634f * x)); }
__device__ __forceinline__ float gelu_tanh(float x) { const float u = 0.7978845608028654f * (x + 0.044715f * x * x * x); return x * sigm(2.f * u); }
__device__ __forceinline__ float wave_sum(float v) {
#pragma unroll
    for (int o = 1; o < 64; o <<= 1) v += __shfl_xor(v, o);
    return v;
}
__device__ __forceinline__ void unpack8(const v4u w, float (&f)[8]) {
    f[0] = __uint_as_float(w.x << 16); f[1] = __uint_as_float(w.x & 0xffff0000u); f[2] = __uint_as_float(w.y << 16); f[3] = __uint_as_float(w.y & 0xffff0000u);
    f[4] = __uint_as_float(w.z << 16); f[5] = __uint_as_float(w.z & 0xffff0000u); f[6] = __uint_as_float(w.w << 16); f[7] = __uint_as_float(w.w & 0xffff0000u);
}
#define LDS_WAIT() asm volatile("s_waitcnt lgkmcnt(0)" ::: "memory")
#define RLX_AGENT __ATOMIC_RELAXED, __HIP_MEMORY_SCOPE_AGENT

namespace pg8 {
typedef unsigned short bf16_t;
typedef unsigned u32x4 __attribute__((ext_vector_type(4)));
constexpr int BM = 256, BK = 64, HALF = 128, HTB = HALF * BK * 2, STAGE_BYTES = 8 * HTB, NXCD = 8, WGM = 8;
__host__ __device__ __forceinline__ int lds_byte(int r, int c) { const int st = (r >> 4) * 2 + (c >> 5), rr = r & 15, cc = c & 31, ob = rr * 64 + cc * 2; return st * 1024 + (ob ^ (((ob >> 9) & 1) << 5)); }
__host__ __device__ __forceinline__ void stage_rc(int b, int& R, int& C) { const int st = b / 1024, sb = b % 1024, swz = sb ^ (((sb >> 9) & 1) << 5); R = (st >> 1) * 16 + swz / 64; C = (st & 1) * 32 + (swz % 64) / 2; }
__host__ __device__ __forceinline__ int perm32(int rho) { const int n = rho >> 4, i = rho & 15; return 8 * (i >> 2) + 4 * n + (i & 3); }

struct Unit { int pm, pn, e, r0, cnt; };

struct StaticOrder {
    int nM, nN, nwg, G, c;
    __device__ void init(int nM_, int nN_, int G_, int c_) { nM = nM_; nN = nN_; nwg = nM * nN; G = G_; c = c_; }
    __device__ bool next(int i, Unit& u) const {
        const long L = (long)i * G + c; if (L >= nwg) return false;
        int wgid = (int)L; { const int q = nwg / NXCD, r = nwg % NXCD, xcd = wgid % NXCD, off = wgid / NXCD; wgid = (xcd < r ? xcd * (q + 1) : r * (q + 1) + (xcd - r) * q) + off; }
        const int nig = WGM * nN, gid = wgid / nig, fm = gid * WGM, gsz = (nM - fm) < WGM ? (nM - fm) : WGM;
        u.pm = fm + ((wgid % nig) % gsz); u.pn = (wgid % nig) / gsz; u.e = 0; u.r0 = 0; u.cnt = 0; return true;
    }
};
struct SchedPlain {
    static constexpr bool GATHER = false;
    StaticOrder so; const char* A; const char* B; size_t tstep;
    __device__ __forceinline__ bool next(int i, Unit& u) const { return so.next(i, u); }
    __device__ __forceinline__ const char* a_ptr(const Unit& u) const { return A + (size_t)u.pm * tstep; }
    __device__ __forceinline__ const char* b_ptr(const Unit& u) const { return B + (size_t)u.pn * tstep; }
    __device__ __forceinline__ void a_offs(const Unit&, const int (&)[2], const int (&)[2], int, unsigned (&)[2][2]) const {}
};
struct SchedMoe {
    StaticOrder so; const LAS int* ts;
    __device__ __forceinline__ bool next(int i, Unit& u) const {
        if (!so.next(i, u)) return false;
        int e = 0;
#pragma unroll
        for (int j = 1; j < 16; ++j) e += (ts[j] <= u.pm) ? 1 : 0;
        e = __builtin_amdgcn_readfirstlane(e);
        u.e = e; u.r0 = (u.pm - __builtin_amdgcn_readfirstlane(ts[e])) * 256; u.cnt = __builtin_amdgcn_readfirstlane(ts[17 + e]); return true;
    }
};
struct SchedMoeGU : SchedMoe {
    static constexpr bool GATHER = true;
    const char* A; const char* B; const int* list;
    __device__ __forceinline__ const char* a_ptr(const Unit&) const { return A; }
    __device__ __forceinline__ const char* b_ptr(const Unit& u) const { return B + (size_t)u.e * (1024 * 1024 * 2) + (size_t)u.pn * (256 * 1024 * 2); }
    __device__ __forceinline__ void a_offs(const Unit& u, const int (&R)[2], const int (&C)[2], int K, unsigned (&v)[2][2]) const {
#pragma unroll
        for (int h = 0; h < 2; ++h)
#pragma unroll
            for (int i = 0; i < 2; ++i) { const int row = u.r0 + h * HALF + R[i]; int tok = 0; if (row < u.cnt) tok = list[u.e * CAP + row]; v[h][i] = (unsigned)(tok * K + C[i]) * 2u; }
    }
};
struct SchedMoeDown : SchedMoe {
    static constexpr bool GATHER = false;
    const char* A; const char* B;
    __device__ __forceinline__ const char* a_ptr(const Unit& u) const { return A + (size_t)u.pm * (256 * 512 * 2); }
    __device__ __forceinline__ const char* b_ptr(const Unit& u) const { return B + (size_t)u.e * (1024 * 512 * 2) + (size_t)u.pn * (256 * 512 * 2); }
    __device__ __forceinline__ void a_offs(const Unit&, const int (&)[2], const int (&)[2], int, unsigned (&)[2][2]) const {}
};

__device__ __forceinline__ unsigned cvt_pk_bf16(float lo, float hi) { unsigned r; asm volatile("v_cvt_pk_bf16_f32 %0, %1, %2" : "=v"(r) : "v"(lo), "v"(hi)); return r; }
struct EpiBf16 {
    static constexpr bool PERM = true;
    bf16_t* O; int ldc;
    __device__ __forceinline__ void operator()(const f32x4 (&acc)[2][2][4][2], const Unit& u, int wr, int wc, int fr, int fq) const {
        const int row0 = u.pm * BM + wr * 64 + fr, col0 = u.pn * BM + wc * 32 + 8 * fq;
#pragma unroll
        for (int ai = 0; ai < 2; ++ai)
#pragma unroll
            for (int m = 0; m < 4; ++m) { bf16_t* rowp = O + (size_t)(row0 + ai * HALF + m * 16) * ldc + col0;
#pragma unroll
                for (int bj = 0; bj < 2; ++bj) { const f32x4 v0 = acc[ai][bj][m][0], v1 = acc[ai][bj][m][1];
                    u32x4 w; w.x = cvt_pk_bf16(v0[0], v0[1]); w.y = cvt_pk_bf16(v0[2], v0[3]); w.z = cvt_pk_bf16(v1[0], v1[1]); w.w = cvt_pk_bf16(v1[2], v1[3]);
                    *(u32x4*)(rowp + bj * HALF) = w; } }
    }
};
struct EpiRes {
    static constexpr bool PERM = true;
    const float* hin_lat; const float* hin_ctx; const bf16_t* hin_bf; bf16_t* hout; const float* gate;
    __device__ __forceinline__ void operator()(const f32x4 (&acc)[2][2][4][2], const Unit& u, int wr, int wc, int fr, int fq) const {
        const int row0 = u.pm * BM + wr * 64 + fr, col0 = u.pn * BM + wc * 32 + 8 * fq;
        const int mi = (u.pm >> 5) > 2 ? 2 : (u.pm >> 5);
        const float* src = (u.pm < 64) ? hin_lat : hin_ctx - (size_t)MLAT * D;
        f32x4 gv[2][2];
#pragma unroll
        for (int bj = 0; bj < 2; ++bj)
#pragma unroll
            for (int n = 0; n < 2; ++n) gv[bj][n] = *(const f32x4*)(gate + mi * 6144 + col0 + bj * HALF + n * 4);
#pragma unroll
        for (int ai = 0; ai < 2; ++ai)
#pragma unroll
            for (int m = 0; m < 4; ++m) { const size_t off = (size_t)(row0 + ai * HALF + m * 16) * D + col0;
#pragma unroll
                for (int bj = 0; bj < 2; ++bj) { f32x4 b0, b1;
                    if (hin_bf) { const u32x4 w = *(const u32x4*)(hin_bf + off + bj * HALF);
                        b0 = (f32x4){__uint_as_float(w.x << 16), __uint_as_float(w.x & 0xffff0000u), __uint_as_float(w.y << 16), __uint_as_float(w.y & 0xffff0000u)};
                        b1 = (f32x4){__uint_as_float(w.z << 16), __uint_as_float(w.z & 0xffff0000u), __uint_as_float(w.w << 16), __uint_as_float(w.w & 0xffff0000u)}; }
                    else { b0 = *(const f32x4*)(src + off + bj * HALF); b1 = *(const f32x4*)(src + off + bj * HALF + 4); }
                    const f32x4 v0 = b0 + gv[bj][0] * acc[ai][bj][m][0], v1 = b1 + gv[bj][1] * acc[ai][bj][m][1];
                    u32x4 w; w.x = cvt_pk_bf16(v0[0], v0[1]); w.y = cvt_pk_bf16(v0[2], v0[3]); w.z = cvt_pk_bf16(v1[0], v1[1]); w.w = cvt_pk_bf16(v1[2], v1[3]);
                    *(u32x4*)(hout + off + bj * HALF) = w; } }
    }
};
struct EpiGateUp {
    static constexpr bool PERM = true;
    bf16_t* Hd;
    __device__ __forceinline__ void operator()(const f32x4 (&acc)[2][2][4][2], const Unit& u, int wr, int wc, int fr, int fq) const {
        const int row0 = u.pm * BM + wr * 64 + fr, col0 = u.pn * HALF + wc * 32 + 8 * fq;
#pragma unroll
        for (int ai = 0; ai < 2; ++ai)
#pragma unroll
            for (int m = 0; m < 4; ++m) { bf16_t* rowp = Hd + (size_t)(row0 + ai * HALF + m * 16) * DFF + col0;
                float h[8];
#pragma unroll
                for (int n = 0; n < 2; ++n)
#pragma unroll
                    for (int j = 0; j < 4; ++j) { const float g = acc[ai][0][m][n][j], up = acc[ai][1][m][n][j]; h[n * 4 + j] = g * sigm(g) * up; }
                u32x4 w; w.x = cvt_pk_bf16(h[0], h[1]); w.y = cvt_pk_bf16(h[2], h[3]); w.z = cvt_pk_bf16(h[4], h[5]); w.w = cvt_pk_bf16(h[6], h[7]);
                *(u32x4*)rowp = w; }
    }
};

struct SchedInproj1 {
    static constexpr bool GATHER = false;
    StaticOrder so; const char* X; const char* W; int G, c;
    __device__ __forceinline__ bool next(int i, Unit& u) const {
        const int L = i * G + c;
        if (L < 640) { return so.next(i, u); }
        if (L < 768) { const int idx = L - 640; u.pm = idx & 1; u.pn = idx >> 1; u.e = 1; u.r0 = 0; u.cnt = 0; return true; }
        return false;
    }
    __device__ __forceinline__ const char* a_ptr(const Unit& u) const { return u.e ? W + (size_t)(10 + u.pm) * (256 * 1024 * 2) : X + (size_t)u.pm * (256 * 1024 * 2); }
    __device__ __forceinline__ const char* b_ptr(const Unit& u) const { return u.e ? X + (size_t)u.pn * (256 * 1024 * 2) : W + (size_t)u.pn * (256 * 1024 * 2); }
    __device__ __forceinline__ void a_offs(const Unit&, const int (&)[2], const int (&)[2], int, unsigned (&)[2][2]) const {}
};
struct EpiInproj1 {
    static constexpr bool PERM = true;
    bf16_t* P; bf16_t* VT;
    __device__ __forceinline__ void operator()(const f32x4 (&acc)[2][2][4][2], const Unit& u, int wr, int wc, int fr, int fq) const {
        const int row0 = u.pm * BM + wr * 64 + fr, col0 = u.pn * BM + wc * 32 + 8 * fq;
        bf16_t* O = u.e ? VT : P; const int ldc = u.e ? MALL : P1LD;
        const float sc = (!u.e && (u.pn == 6 || u.pn == 7)) ? QSCALE : 1.0f;
#pragma unroll
        for (int ai = 0; ai < 2; ++ai)
#pragma unroll
            for (int m = 0; m < 4; ++m) { bf16_t* rowp = O + (size_t)(row0 + ai * HALF + m * 16) * ldc + col0;
#pragma unroll
                for (int bj = 0; bj < 2; ++bj) { const f32x4 v0 = acc[ai][bj][m][0] * sc, v1 = acc[ai][bj][m][1] * sc;
                    u32x4 w; w.x = cvt_pk_bf16(v0[0], v0[1]); w.y = cvt_pk_bf16(v0[2], v0[3]); w.z = cvt_pk_bf16(v1[0], v1[1]); w.w = cvt_pk_bf16(v1[2], v1[3]);
                    *(u32x4*)(rowp + bj * HALF) = w; } }
    }
};

template <class Epi, class Sched, bool ALIGN_EPI, bool SP2>
__device__ __forceinline__ void gemm_phase(LAS unsigned char* lds, const int K, const Sched& S, const Epi& E) {
    const int tid = threadIdx.x, wid = __builtin_amdgcn_readfirstlane(tid >> 6), lane = tid & 63, wr = wid >> 2, wc = wid & 3, fr = lane & 15, fq = lane >> 4;
    const int nt = K / BK;
    const size_t kstep = (size_t)(BK * 2);
    const size_t hstep = (size_t)HALF * K * 2;
    int Rr[2], Cc[2]; unsigned voffB[2], vA[2][2], nvA[2][2];
#pragma unroll
    for (int i = 0; i < 2; ++i) { int R, C; stage_rc(tid * 16 + i * 8192, R, C); Rr[i] = R; Cc[i] = C; const int Rb = Epi::PERM ? ((R & ~31) + perm32(R & 31)) : R;
        voffB[i] = (unsigned)(Rb * K + C) * 2u; vA[0][i] = (unsigned)(R * K + C) * 2u; vA[1][i] = vA[0][i] + (unsigned)hstep; nvA[0][i] = vA[0][i]; nvA[1][i] = vA[1][i]; }
    const unsigned ldsw = (unsigned)wid * 1024u;
    const int aoff = lds_byte(wr * 64 + fr, fq * 8), boff = lds_byte(wc * 32 + fr, fq * 8);
#define PG8_SA(b, h) (((b) * 2 + (h)) * HTB)
#define PG8_SB(b, h) ((4 + (b) * 2 + (h)) * HTB)
#define PG8_STAGE(bufoff, gbase, voff) do { _Pragma("unroll") for (int _i = 0; _i < 2; ++_i) \
        __builtin_amdgcn_global_load_lds((const unsigned*)((const char*)(gbase) + (voff)[_i]), (LAS unsigned*)(lds + (bufoff) + ldsw + _i * 8192), 16, 0, 0); } while (0)
#define PG8_LDA(dst, b, h) do { _Pragma("unroll") for (int m = 0; m < 4; ++m) _Pragma("unroll") for (int k = 0; k < 2; ++k) dst[m][k] = *(const LAS bf16x8*)(lds + PG8_SA(b, h) + aoff + m * 2048 + k * 1024); } while (0)
#define PG8_LDB(dst, b, h) do { _Pragma("unroll") for (int n = 0; n < 2; ++n) _Pragma("unroll") for (int k = 0; k < 2; ++k) dst[n][k] = *(const LAS bf16x8*)(lds + PG8_SB(b, h) + boff + n * 2048 + k * 1024); } while (0)
#define PG8_MMA(ai, bj, At, Bt) do { __builtin_amdgcn_s_setprio(1); _Pragma("unroll") for (int m = 0; m < 4; ++m) _Pragma("unroll") for (int n = 0; n < 2; ++n) _Pragma("unroll") for (int k = 0; k < 2; ++k) \
        acc[ai][bj][m][n] = __builtin_amdgcn_mfma_f32_16x16x32_bf16(Bt[n][k], At[m][k], acc[ai][bj][m][n], 0, 0, 0); __builtin_amdgcn_s_setprio(0); } while (0)
#define PG8_WAIT_V(n) asm volatile("s_waitcnt vmcnt(" #n ")" ::: "memory")
#define PG8_WAIT_L(n) asm volatile("s_waitcnt lgkmcnt(" #n ")" ::: "memory")
#define PG8_BAR __builtin_amdgcn_s_barrier()
#define PG8_SCHED __builtin_amdgcn_sched_barrier(0)
    Unit cur, nxt; int ui = 0;
    if (!S.next(0, cur)) return;
    if constexpr (Sched::GATHER) { S.a_offs(cur, Rr, Cc, K, vA); }
    f32x4 acc[2][2][4][2];
#pragma unroll
    for (int a = 0; a < 2; ++a)
#pragma unroll
        for (int b = 0; b < 2; ++b)
#pragma unroll
            for (int m = 0; m < 4; ++m)
#pragma unroll
                for (int n = 0; n < 2; ++n) acc[a][b][m][n] = (f32x4){0.f, 0.f, 0.f, 0.f};
    bf16x8 At[4][2], B0[2][2], B1[2][2];
    const char* cA = S.a_ptr(cur); const char* cB = S.b_ptr(cur);
    static_assert(SP2, "only the two-super-phase loop is kept");
    PG8_STAGE(PG8_SB(0, 0), cB, voffB); PG8_STAGE(PG8_SB(0, 1), cB + hstep, voffB); PG8_STAGE(PG8_SA(0, 0), cA, vA[0]); PG8_STAGE(PG8_SA(0, 1), cA, vA[1]);
    if (wr == 1) PG8_BAR;
    PG8_WAIT_V(2); PG8_BAR;
    PG8_STAGE(PG8_SB(1, 0), cB + kstep, voffB); PG8_STAGE(PG8_SA(1, 0), cA + kstep, vA[0]); PG8_STAGE(PG8_SB(1, 1), cB + hstep + kstep, voffB);
    PG8_WAIT_V(6); PG8_BAR;
    for (;;) {
        const bool has_next = S.next(ui + 1, nxt);
        const char* nA = has_next ? S.a_ptr(nxt) : cA; const char* nB = has_next ? S.b_ptr(nxt) : cB;
        if constexpr (Sched::GATHER) { if (has_next) S.a_offs(nxt, Rr, Cc, K, nvA); }
        for (int t = 0; t < nt; t += 2) {
            const bool last = (t == nt - 2);
            const char* a1 = cA + (size_t)(t + 1) * kstep;
            const char* a2 = last ? nA : cA + (size_t)(t + 2) * kstep; const char* b2 = last ? nB : cB + (size_t)(t + 2) * kstep;
            const char* a3 = a2 + kstep; const char* b3 = b2 + kstep;
            unsigned wA[2][2];
#pragma unroll
            for (int h = 0; h < 2; ++h)
#pragma unroll
                for (int i = 0; i < 2; ++i) wA[h][i] = (Sched::GATHER && last) ? nvA[h][i] : vA[h][i];
            PG8_LDB(B0, 0, 0); PG8_LDB(B1, 0, 1); PG8_SCHED; PG8_LDA(At, 0, 0); PG8_STAGE(PG8_SA(1, 1), a1, vA[1]);
            PG8_WAIT_V(8); PG8_WAIT_L(0); PG8_BAR; PG8_MMA(0, 0, At, B0); PG8_MMA(0, 1, At, B1); PG8_BAR; PG8_SCHED;
            PG8_LDA(At, 0, 1); PG8_STAGE(PG8_SB(0, 0), b2, voffB); PG8_STAGE(PG8_SB(0, 1), b2 + hstep, voffB); PG8_STAGE(PG8_SA(0, 0), a2, wA[0]);
            PG8_WAIT_V(8); PG8_WAIT_L(0); PG8_BAR; PG8_MMA(1, 0, At, B0); PG8_MMA(1, 1, At, B1); PG8_BAR; PG8_SCHED;
            PG8_LDB(B0, 1, 0); PG8_LDB(B1, 1, 1); PG8_SCHED; PG8_LDA(At, 1, 0); PG8_STAGE(PG8_SA(0, 1), a2, wA[1]);
            PG8_WAIT_V(8); PG8_WAIT_L(0); PG8_BAR; PG8_MMA(0, 0, At, B0); PG8_MMA(0, 1, At, B1); PG8_BAR; PG8_SCHED;
            PG8_LDA(At, 1, 1); PG8_STAGE(PG8_SB(1, 0), b3, voffB); PG8_STAGE(PG8_SB(1, 1), b3 + hstep, voffB); PG8_STAGE(PG8_SA(1, 0), a3, wA[0]);
            PG8_WAIT_V(8); PG8_WAIT_L(0); PG8_BAR; PG8_MMA(1, 0, At, B0); PG8_MMA(1, 1, At, B1); PG8_BAR; PG8_SCHED;
        }
        if constexpr (ALIGN_EPI) { if (wr == 0) PG8_BAR; }
        E(acc, cur, wr, wc, fr, fq);
        if (!has_next) break;
#pragma unroll
        for (int a = 0; a < 2; ++a)
#pragma unroll
            for (int b = 0; b < 2; ++b)
#pragma unroll
                for (int m = 0; m < 4; ++m)
#pragma unroll
                    for (int n = 0; n < 2; ++n) acc[a][b][m][n] = (f32x4){0.f, 0.f, 0.f, 0.f};
        cur = nxt; cA = nA; cB = nB; ++ui;
        if constexpr (Sched::GATHER) {
#pragma unroll
            for (int h = 0; h < 2; ++h)
#pragma unroll
                for (int i = 0; i < 2; ++i) vA[h][i] = nvA[h][i];
        }
        if constexpr (ALIGN_EPI) { if (wr == 1) PG8_BAR; }
    }
    PG8_WAIT_V(0);
    if constexpr (!ALIGN_EPI) { if (wr == 0) PG8_BAR; }
    PG8_BAR;
#undef PG8_SA
#undef PG8_SB
#undef PG8_STAGE
#undef PG8_LDA
#undef PG8_LDB
#undef PG8_MMA
#undef PG8_WAIT_V
#undef PG8_WAIT_L
#undef PG8_BAR
#undef PG8_SCHED
}
}

typedef GAS unsigned gu32;
#define XB_TMO      128
#define XB_XCNT(j)  (256  + 64 * (j))
#define XB_XSUB(j)  (1280 + 64 * (j))
#define XB_XGEN(j)  (2304 + 64 * (j))
#define XB_TOP      3328
#define XB_TOPGEN   3392
#define XCD_BAR_WORDS 3456
#define XB_SPIN_CAP (1u << 20)
__device__ __forceinline__ unsigned xb_ld(unsigned* p)              { return __hip_atomic_load(p, __ATOMIC_RELAXED, __HIP_MEMORY_SCOPE_AGENT); }
__device__ __forceinline__ unsigned xb_add(unsigned* p, unsigned v) { return __hip_atomic_fetch_add(p, v, __ATOMIC_RELAXED, __HIP_MEMORY_SCOPE_AGENT); }
__device__ __forceinline__ unsigned xb_xcc_id() { return (unsigned)__builtin_amdgcn_s_getreg((3 << 11) | 20) & 0xFu; }
#define XB_SPIN(cond, bar) do { unsigned _sp = 0; while (cond) { __builtin_amdgcn_s_sleep(1); \
    if ((++_sp & 255u) == 0u) { if (xb_ld(&(bar)[XB_TMO])) break; if (_sp > XB_SPIN_CAP) { atomicAdd(&(bar)[XB_TMO], 1u); break; } } } } while (0)
struct XcdBarrier { unsigned* bar; unsigned x; volatile LAS unsigned* st; };
__device__ __forceinline__ XcdBarrier xcd_barrier_post(unsigned* bar, volatile LAS unsigned* st) {
    XcdBarrier b; b.bar = bar; b.x = xb_xcc_id(); b.st = st;
    if (threadIdx.x == 0) (void)xb_add(&bar[XB_XCNT(b.x)], 1u);
    return b;
}
__device__ __forceinline__ void xcd_barrier_complete(unsigned* bar, unsigned x, unsigned& nloc, unsigned& nx) {
    const unsigned G = gridDim.x * gridDim.y * gridDim.z;
    unsigned sum, cnt, mine, sp = 0u;
    for (;;) {
        sum = 0u; cnt = 0u; mine = 0u;
#pragma unroll
        for (unsigned j = 0; j < 16; ++j) { const unsigned c = xb_ld(&bar[XB_XCNT(j)]); sum += c; cnt += (c > 0u) ? 1u : 0u; mine = (j == x) ? c : mine; }
        if (sum == G) break;
        __builtin_amdgcn_s_sleep(1);
        if ((++sp & 255u) == 0u) { if (xb_ld(&bar[XB_TMO])) break; if (sp > XB_SPIN_CAP) { atomicAdd(&bar[XB_TMO], 1u); break; } }
    }
    nloc = mine > 0u ? mine : 1u; nx = cnt > 0u ? cnt : 1u;
}
__device__ __forceinline__ void xcd_barrier(const XcdBarrier& b) {
    asm volatile("s_waitcnt vmcnt(0)" ::: "memory");
    __syncthreads();
    if (threadIdx.x == 0) {
        unsigned* bar = b.bar;
        __builtin_amdgcn_s_waitcnt(0);
        unsigned nloc = b.st[0], nx = b.st[1];
        if (nloc == 0u) { xcd_barrier_complete(bar, b.x, nloc, nx); b.st[0] = nloc; b.st[1] = nx; }
        const unsigned old = xb_add(&bar[XB_XSUB(b.x)], 1u);
        const unsigned gen = old / nloc;
        if (old + 1u == (gen + 1u) * nloc) {
            __builtin_amdgcn_fence(__ATOMIC_RELEASE, "agent");
            asm volatile("s_waitcnt vmcnt(0)" ::: "memory");
            const unsigned og = xb_add(&bar[XB_TOP], 1u);
            const unsigned tg = og / nx;
            if (og + 1u == (tg + 1u) * nx) xb_add(&bar[XB_TOPGEN], 1u);
            else XB_SPIN(xb_ld(&bar[XB_TOPGEN]) == tg, bar);
            __builtin_amdgcn_fence(__ATOMIC_ACQUIRE, "agent");
            xb_add(&bar[XB_XGEN(b.x)], 1u);
            asm volatile("s_waitcnt vmcnt(0)" ::: "memory");
        } else {
            XB_SPIN(xb_ld(&bar[XB_XGEN(b.x)]) == gen, bar);
            __builtin_amdgcn_fence(__ATOMIC_ACQUIRE, "agent");
            asm volatile("s_waitcnt vmcnt(0)" ::: "memory");
        }
    }
    __syncthreads();
}

struct Frame {
    LAS unsigned char* lds;
    volatile LAS unsigned* MISC;
    gu32* ctl;
    int tid, lane, wave, vcu, G, sub;
    const float *x, *c, *ctx, *c_ctx, *ada_w, *ada_b, *gmix, *gffn, *w_out, *ab_w_in, *a_dw_w, *a_dw_b, *a_ln_g, *a_ln_b, *b_conv_w, *b_conv_b, *b_gate_w, *b_gate_b, *b_lambda,
        *cd_w_in, *c_conv_w, *d_rpb, *router_w, *router_bias, *moe_wg, *moe_wu, *moe_wd, *final_g;
    float* out;
    float* mod; float* sum; int* list; int* rslot; float* rw;
    bf16 *Wab, *Wout, *Wcd, *Wgu, *Wd, *WgT;
    bf16 *XN, *P, *Y, *HID, *VT; bf16* H; unsigned* AB;
};

__device__ __forceinline__ void p0_transpose_item(const float* W, int K, int N, bf16* WT, int rbase, int rstride, LAS float* scr, int item, int lane) {
    const int nblk = N / 32, kb = item / nblk, nb = item % nblk, k0 = 64 * kb, n0 = 32 * nb;
    const int orow0 = rbase + (n0 >> 7) * rstride + (n0 & 127);
    { const int kr = lane >> 3, nq = lane & 7; f32x4 v[8];
#pragma unroll
      for (int i = 0; i < 8; ++i) v[i] = *(const f32x4*)(W + (size_t)(k0 + 8 * i + kr) * N + n0 + 4 * nq);
#pragma unroll
      for (int i = 0; i < 8; ++i) { LAS float* d = scr + (8 * i + kr) * 33 + 4 * nq; d[0] = v[i].x; d[1] = v[i].y; d[2] = v[i].z; d[3] = v[i].w; } }
    LDS_WAIT(); asm volatile("" ::: "memory");
    const int c = lane & 7;
#pragma unroll
    for (int j = 0; j < 4; ++j) { const int n = (lane >> 3) + 8 * j; const LAS float* s = scr + (8 * c) * 33 + n;
        v4u o; o.x = pk2(s[0 * 33], s[1 * 33]); o.y = pk2(s[2 * 33], s[3 * 33]); o.z = pk2(s[4 * 33], s[5 * 33]); o.w = pk2(s[6 * 33], s[7 * 33]);
        *(GAS v4u*)(WT + (size_t)(orow0 + n) * K + k0 + 8 * c) = o; }
    LDS_WAIT(); asm volatile("" ::: "memory");
}

__device__ __forceinline__ void p0_prologue(Frame& F) {
    LAS float* condL = (LAS float*)F.lds;
    LAS float* red = condL + 3 * 1024;
    for (int i = F.tid; i < 3072; i += NWAVES * 64) { const int m = i >> 10, k = i & 1023; const float cv = (m < 2) ? F.c[m * 1024 + k] : F.c_ctx[k]; condL[i] = cv * sigm(cv); }
    __syncthreads();
    if (blockIdx.x < 192) {
        const int cg = blockIdx.x, layer = cg / 96, col0 = (cg % 96) * 64;
        const float* W = F.ada_w + (size_t)layer * 1024 * 6144 + col0 + F.lane;
        const int k0 = F.wave * 128;
        float a0 = 0.f, a1 = 0.f, a2 = 0.f;
#pragma unroll 32
        for (int kk = 0; kk < 128; ++kk) { const int k = k0 + kk; const float w = W[(size_t)k * 6144]; a0 += condL[k] * w; a1 += condL[1024 + k] * w; a2 += condL[2048 + k] * w; }
        red[(F.wave * 3 + 0) * 64 + F.lane] = a0; red[(F.wave * 3 + 1) * 64 + F.lane] = a1; red[(F.wave * 3 + 2) * 64 + F.lane] = a2;
        __syncthreads();
        if (F.tid < 192) { const int m = F.tid >> 6, l = F.tid & 63; float s = 0.f;
#pragma unroll
            for (int w = 0; w < 8; ++w) s += red[(w * 3 + m) * 64 + l];
            F.mod[(layer * 3 + m) * 6144 + col0 + l] = s + F.ada_b[layer * 6144 + col0 + l]; }
    }
    __syncthreads();
    LAS float* scr = (LAS float*)(F.lds + F.wave * 16384);
    const int gw = F.vcu * NWAVES + F.wave, NGW = F.G * NWAVES;
    constexpr int I_AB = 16 * 64, I_OUT = 16 * 32, I_CD = 16 * 96, I_G = 16 * 16, I_DN = 8 * 32;
    constexpr int I_GW = 2 * 4;
    constexpr int NITEMS = 16 * I_GW + I_AB + 2 * I_OUT + I_CD + 32 * (2 * I_G + I_DN);
    for (int it = gw; it < NITEMS; it += NGW) {
        int r = it;
        if (r < 16 * I_GW) { const int blk = r / I_GW; p0_transpose_item(F.b_gate_w + (size_t)blk * 16384, 128, 128, F.WgT + (size_t)blk * 16384, 0, 128, scr, r % I_GW, F.lane); continue; } r -= 16 * I_GW;
        if (r < I_AB) { p0_transpose_item(F.ab_w_in, 1024, 2048, F.Wab, 0, 128, scr, r, F.lane); continue; } r -= I_AB;
        if (r < 2 * I_OUT) { const int l = r / I_OUT; p0_transpose_item(F.w_out + (size_t)l * 1024 * 1024, 1024, 1024, F.Wout + (size_t)l * 1024 * 1024, 0, 128, scr, r % I_OUT, F.lane); continue; } r -= 2 * I_OUT;
        if (r < I_CD) { p0_transpose_item(F.cd_w_in, 1024, 3072, F.Wcd, 0, 128, scr, r, F.lane); continue; } r -= I_CD;
        if (r < 32 * I_G) { const int le = r / I_G; p0_transpose_item(F.moe_wg + (size_t)le * 1024 * 512, 1024, 512, F.Wgu + (size_t)le * 1024 * 1024, 0, 256, scr, r % I_G, F.lane); continue; } r -= 32 * I_G;
        if (r < 32 * I_G) { const int le = r / I_G; p0_transpose_item(F.moe_wu + (size_t)le * 1024 * 512, 1024, 512, F.Wgu + (size_t)le * 1024 * 1024, 128, 256, scr, r % I_G, F.lane); continue; } r -= 32 * I_G;
        { const int le = r / I_DN; p0_transpose_item(F.moe_wd + (size_t)le * 512 * 1024, 512, 1024, F.Wd + (size_t)le * 1024 * 512, 0, 128, scr, r % I_DN, F.lane); }
    }
}

__device__ __forceinline__ void norm_mod_store(const f32x4 (&v)[4], const float* g, const float* sc, const float* sh, bf16* dst, int lane, f32x4 (&t)[4]) {
    float s = 0.f;
#pragma unroll
    for (int j = 0; j < 4; ++j) s += (v[j].x * v[j].x + v[j].y * v[j].y) + (v[j].z * v[j].z + v[j].w * v[j].w);
    const float rstd = 1.f / sqrtf(wave_sum(s) * (1.f / D) + EPS);
#pragma unroll
    for (int j = 0; j < 4; ++j) { const int col = 4 * lane + 256 * j;
        const f32x4 gg = *(const f32x4*)(g + col), ss = *(const f32x4*)(sc + col), hh = *(const f32x4*)(sh + col);
        t[j] = v[j] * rstd * gg * (ss + 1.0f) + hh;
        v2u o; o.x = pk2(t[j].x, t[j].y); o.y = pk2(t[j].z, t[j].w);
        *(v2u*)(dst + col) = o; }
}

__device__ __forceinline__ void p1_norm0(Frame& F) {
    const int gw = F.vcu * NWAVES + F.wave, NGW = F.G * NWAVES;
    for (int row = gw; row < MALL; row += NGW) {
        const float* src = (row < MLAT) ? F.x + (size_t)row * D : F.ctx + (size_t)(row - MLAT) * D;
        const int mi = (row >> 13) > 2 ? 2 : (row >> 13);
        f32x4 v[4], t[4];
#pragma unroll
        for (int j = 0; j < 4; ++j) v[j] = *(const f32x4*)(src + 4 * F.lane + 256 * j);
        const float* md = F.mod + (0 * 3 + mi) * 6144;
        norm_mod_store(v, F.gmix, md + 1024, md, F.XN + (size_t)row * D, F.lane, t);
    }
}

template <int NT>
__device__ __forceinline__ void conf_unit(Frame& F, int row0) {
    int seq0, L;
    if (row0 < MLAT) { seq0 = (row0 >> 13) << 13; L = SEQ; } else { seq0 = MLAT + (((row0 - MLAT) >> 8) << 8); L = CTXL; }
    const int t0 = row0 - seq0, ch = F.tid;
    constexpr int NR = NT + 30, NIT = (NR * 64 + 511) / 512, TGS = (NT >= 4) ? 4 : NT, NG = NT / TGS;
    LAS bf16* ub = (LAS bf16*)F.lds;
    LAS float* ol = (LAS float*)(F.lds + 62 * 512 * 2);
    LAS float* red = (LAS float*)(F.lds + 62 * 512 * 2 + 32 * 512 * 4);
    LAS float* fin = red + 512;
    {
        v4u rv[NIT], rg[NIT];
#pragma unroll
        for (int k = 0; k < NIT; ++k) { const int it = F.tid + 512 * k; const int r = it >> 6, c8 = (it & 63) * 8; const int t = t0 - 15 + r; const int tc = t < 0 ? 0 : (t >= L ? L - 1 : t);
            if (it < NR * 64) { const bf16* p = F.P + (size_t)(seq0 + tc) * 2048 + c8; rv[k] = *(const v4u*)p; rg[k] = *(const v4u*)(p + 512); } }
#pragma unroll
        for (int k = 0; k < NIT; ++k) { const int it = F.tid + 512 * k; const int r = it >> 6, c8 = (it & 63) * 8; const int t = t0 - 15 + r; const bool ok = (t >= 0 && t < L);
            if (it < NR * 64) { float fv[8], fg[8]; unpack8(rv[k], fv); unpack8(rg[k], fg); float uo[8];
#pragma unroll
                for (int j = 0; j < 8; ++j) uo[j] = ok ? fv[j] * sigm(fg[j]) : 0.f;
                v4u w; w.x = pk2(uo[0], uo[1]); w.y = pk2(uo[2], uo[3]); w.z = pk2(uo[4], uo[5]); w.w = pk2(uo[6], uo[7]);
                *(LAS v4u*)(ub + r * 512 + c8) = w; } }
    }
    float wk[31];
#pragma unroll
    for (int k = 0; k < 31; ++k) wk[k] = F.a_dw_w[k * 512 + ch];
    const float bias = F.a_dw_b[ch];
    __syncthreads();
#pragma unroll 1
    for (int tg = 0; tg < NG; ++tg) {
        const LAS bf16* up = ub + (tg * TGS) * 512 + ch;
        float uu[TGS + 30];
#pragma unroll
        for (int i = 0; i < TGS + 30; ++i) uu[i] = bf2f(up[i * 512]);
        float o4[TGS];
#pragma unroll
        for (int j = 0; j < TGS; ++j) o4[j] = bias;
#pragma unroll
        for (int k = 0; k < 31; ++k)
#pragma unroll
            for (int j = 0; j < TGS; ++j) o4[j] += wk[k] * uu[j + k];
#pragma unroll
        for (int j = 0; j < TGS; ++j) ol[(tg * TGS + j) * 512 + ch] = o4[j];
    }
    float o[NT];
#pragma unroll
    for (int t = 0; t < NT; ++t) o[t] = ol[t * 512 + ch];
    float mine = 0.f;
    if constexpr (NT == 32) {
        float x[64];
#pragma unroll
        for (int t = 0; t < 32; ++t) { x[t] = o[t]; x[32 + t] = o[t] * o[t]; }
#pragma unroll
        for (int s5 = 0; s5 < 6; ++s5) { const int off = 32 >> s5; const bool up2 = (F.lane & off) != 0;
#pragma unroll
            for (int j = 0; j < off; ++j) { const float a = x[j], bq = x[j + off]; const float send = up2 ? a : bq, keep = up2 ? bq : a; x[j] = keep + __shfl_xor(send, off); } }
        mine = x[0];
    } else {
#pragma unroll
        for (int t = 0; t < NT; ++t) { const float sv = wave_sum(o[t]), q = wave_sum(o[t] * o[t]); mine = (F.lane == t) ? sv : mine; mine = (F.lane == 32 + t) ? q : mine; }
    }
    red[F.wave * 64 + F.lane] = mine;
    __syncthreads();
    if (F.tid < 64) { float sv = 0.f;
#pragma unroll
        for (int w = 0; w < 8; ++w) sv += red[w * 64 + F.tid];
        fin[F.tid] = sv; }
    __syncthreads();
    const float lg = F.a_ln_g[ch], lb = F.a_ln_b[ch];
    LAS bf16* ot = (LAS bf16*)F.lds;
#pragma unroll
    for (int t = 0; t < NT; ++t) { const float mean = fin[t] * (1.f / 512.f); float var = fin[32 + t] * (1.f / 512.f) - mean * mean; var = var < 0.f ? 0.f : var;
        const float y = (o[t] - mean) * __builtin_amdgcn_rsqf(var + EPS) * lg + lb;
        ot[t * 512 + ch] = (bf16)f2bf(y * sigm(y)); }
    __syncthreads();
#pragma unroll
    for (int k = 0; k < (NT * 64 + 511) / 512; ++k) { const int it = F.tid + 512 * k; const int r = it >> 6, c8 = (it & 63) * 8;
        if (it < NT * 64) *(v4u*)(F.XN + (size_t)(row0 + r) * D + c8) = *(const LAS v4u*)(ot + r * 512 + c8); }
    __syncthreads();
}

typedef float f32x16 __attribute__((ext_vector_type(16)));
constexpr int LRU_VSB = 0, LRU_VS = 17408, LRU_PRE = LRU_VS + 32768, LRU_SUB = LRU_PRE + 65536, LRU_CIN = LRU_SUB + 8192, LRU_CAR = LRU_CIN + 4096, LRU_TMP = LRU_CAR + 4096, LRU_CST = LRU_TMP + 1024;
static_assert(LRU_CST + 11 * 128 * 4 <= SCR_BYTES, "lru lds map");
__device__ __forceinline__ void lru_carries(Frame& F, int b, int n, bool is_lat, int c0, int nch) {
    LAS float* car = (LAS float*)(F.lds + LRU_CAR);
    LAS float* tmp = (LAS float*)(F.lds + LRU_TMP);
    const int ch = F.tid & 127, dir = (F.tid >> 7) & 1, half = F.tid >> 8, cidx = 128 * n + ch;
    const int nlat_all = is_lat ? 128 : 0, nctx = is_lat ? 4 : 0;
    const int top = is_lat ? 127 : 3;
    const int nown = dir ? (top - (c0 + nch - 1)) : c0;
    const int Ltot = nctx + nown, mid = Ltot >> 1;
    const int i0 = half ? mid : 0, i1 = half ? Ltot : mid;
    const float* sb = F.sum + ((size_t)dir * 512 + cidx) * 2;
    float A = 1.f, B = 0.f;
    for (int ib = i0; ib < i1; ib += 8) {
        float As[8], Bs[8];
#pragma unroll
        for (int j = 0; j < 8; ++j) { int i = ib + j; i = i < i1 ? i : i1 - 1;
            int scn;
            if (i < nctx) scn = 4 * b + (dir ? 3 - i : i);
            else { const int k = i - nctx; const int cc = dir ? top - k : k; scn = is_lat ? 8 + 128 * b + cc : 4 * b + cc; }
            const float* p = sb + (size_t)scn * 2048; As[j] = p[0]; Bs[j] = p[1]; }
#pragma unroll
        for (int j = 0; j < 8; ++j) if (ib + j < i1) { B = As[j] * B + Bs[j]; A *= As[j]; }
    }
    if (half == 0) tmp[F.tid] = B;
    __syncthreads();
    if (half == 1) {
        float h = A * tmp[F.tid - 256] + B;
        if (dir == 0) { for (int i = 0; i < nch; ++i) { car[(i * 2 + 0) * 128 + ch] = h; const int scn = is_lat ? 8 + 128 * b + c0 + i : 4 * b + c0 + i; const float* p = sb + (size_t)scn * 2048; h = p[0] * h + p[1]; } }
        else { for (int i = nch - 1; i >= 0; --i) { car[(i * 2 + 1) * 128 + ch] = h; const int scn = is_lat ? 8 + 128 * b + c0 + i : 4 * b + c0 + i; const float* p = sb + (size_t)scn * 2048; h = p[0] * h + p[1]; } }
    }
    __syncthreads();
}
__device__ __forceinline__ void lru_group(Frame& F, int b, int n, bool is_lat, int c0, int nch, bool final) {
    const int seq0 = is_lat ? b * SEQ : MLAT + b * CTXL, L = is_lat ? SEQ : CTXL;
    const int ch = F.tid & 127, tq = F.tid >> 7, cidx = 128 * n + ch;
    LAS bf16* vsb = (LAS bf16*)(F.lds + LRU_VSB);
    LAS float* vs = (LAS float*)(F.lds + LRU_VS);
    LAS float* pre = (LAS float*)(F.lds + LRU_PRE);
    LAS float* sub = (LAS float*)(F.lds + LRU_SUB);
    LAS float* cin = (LAS float*)(F.lds + LRU_CIN);
    LAS float* cst = (LAS float*)(F.lds + LRU_CST);
    const LAS float* car = (const LAS float*)(F.lds + LRU_CAR);
    if (F.tid < 128) {
#pragma unroll
        for (int k = 0; k < 4; ++k) cst[k * 128 + ch] = F.b_conv_w[k * 512 + cidx];
        cst[4 * 128 + ch] = F.b_conv_b[cidx];
#pragma unroll
        for (int d = 0; d < 2; ++d) { const float lam = F.b_lambda[d * 512 + cidx]; const float el = __expf(-lam);
            cst[(5 + 3 * d) * 128 + ch] = (el < 0.05f) ? el * (1.f + el * (-0.5f + el * (0.33333333f - 0.25f * el))) : log1pf(el);
            cst[(6 + 3 * d) * 128 + ch] = F.b_gate_b[(d * 2 + 0) * 512 + cidx]; cst[(7 + 3 * d) * 128 + ch] = F.b_gate_b[(d * 2 + 1) * 512 + cidx]; }
    }
    if (final) lru_carries(F, b, n, is_lat, c0, nch); else __syncthreads();
    const int g = F.wave & 1, th = (F.wave >> 1) & 1, chh = F.wave >> 2, l31 = F.lane & 31, hk = F.lane >> 5;
    const bf16* wt0 = F.WgT + ((size_t)(g * 4 + n) * 128 + 64 * chh + l31) * 128 + 8 * hk;
    for (int i = 0; i < nch; ++i) {
        int c = c0 + i; asm volatile("" : "+s"(c));
        const int t0 = c * 64;
        const int sc = is_lat ? 8 + 128 * b + c : 4 * b + c;
        LAS bf16* ub = (LAS bf16*)(F.lds + LRU_VSB);
        v4u gq[2];
        {
            v4u ur[3];
#pragma unroll
            for (int k = 0; k < 3; ++k) { const int it = F.tid + 512 * k; const int r = it >> 4, c8 = (it & 15) * 8; const int t = t0 - 2 + r; const int tc = t < 0 ? 0 : (t >= L ? L - 1 : t);
                if (it < 67 * 16) { ur[k] = *(const v4u*)(F.P + (size_t)(seq0 + tc) * 2048 + 1024 + 128 * n + c8); if (t != tc) ur[k] = (v4u){0u, 0u, 0u, 0u}; } }
            if (final) {
#pragma unroll
                for (int k = 0; k < 2; ++k) { const int it = F.tid + 512 * k; const int r = it >> 4, c8 = (it & 15) * 8; gq[k] = *(const v4u*)(F.P + (size_t)(seq0 + t0 + r) * 2048 + 1536 + 128 * n + c8); } }
#pragma unroll
            for (int k = 0; k < 3; ++k) { const int it = F.tid + 512 * k; const int r = it >> 4, c8 = (it & 15) * 8; if (it < 67 * 16) *(LAS v4u*)(ub + r * 128 + c8) = ur[k]; }
        }
        __syncthreads();
        {
            float uu[19];
#pragma unroll
            for (int tt = 0; tt < 19; ++tt) uu[tt] = bf2f(ub[(tq * 16 + tt) * 128 + ch]);
            __syncthreads();
            const float w0 = cst[ch], w1 = cst[128 + ch], w2 = cst[256 + ch], w3 = cst[384 + ch], cb = cst[512 + ch];
#pragma unroll
            for (int t = 0; t < 16; ++t) { const float v = cb + w0 * uu[t] + w1 * uu[t + 1] + w2 * uu[t + 2] + w3 * uu[t + 3]; vs[(tq * 16 + t) * 128 + ch] = v; vsb[(tq * 16 + t) * 136 + ch] = (bf16)f2bf(v); }
        }
        __syncthreads();
        LAS bf16* gb = (LAS bf16*)(F.lds + LRU_PRE);
        float y[16];
#pragma unroll
        for (int d = 0; d < 2; ++d) {
            {
                bf16x8 Bq[2][8];
#pragma unroll
                for (int cb = 0; cb < 2; ++cb)
#pragma unroll
                    for (int ks = 0; ks < 8; ++ks) Bq[cb][ks] = *(const bf16x8*)(wt0 + (size_t)d * 131072 + (size_t)(32 * cb) * 128 + 16 * ks);
                __builtin_amdgcn_sched_barrier(0);
#pragma unroll
                for (int cb = 0; cb < 2; ++cb) {
                    f32x16 a16 = {0.f, 0.f, 0.f, 0.f, 0.f, 0.f, 0.f, 0.f, 0.f, 0.f, 0.f, 0.f, 0.f, 0.f, 0.f, 0.f};
#pragma unroll
                    for (int ks = 0; ks < 8; ++ks) { const bf16x8 Af = *(const LAS bf16x8*)(vsb + (32 * th + l31) * 136 + 16 * ks + 8 * hk); a16 = __builtin_amdgcn_mfma_f32_32x32x16_bf16(Af, Bq[cb][ks], a16, 0, 0, 0); }
#pragma unroll
                    for (int r = 0; r < 16; ++r) pre[(g * 64 + 32 * th + (r & 3) + 8 * (r >> 2) + 4 * hk) * 128 + 64 * chh + 32 * cb + l31] = a16[r];
                }
            }
            __syncthreads();
            float av[16], bv[16];
            {
                const float spd = cst[(5 + 3 * d) * 128 + ch], br = cst[(6 + 3 * d) * 128 + ch], bi = cst[(7 + 3 * d) * 128 + ch];
                {
#pragma unroll
                for (int t = 0; t < 16; ++t) { const float r = sigm(pre[(tq * 16 + t) * 128 + ch] + br), ii = sigm(pre[(64 + tq * 16 + t) * 128 + ch] + bi);
                    const float la = -8.0f * r * spd; const float a = __expf(la); const float ep = 1.f - a; const float bm = __builtin_amdgcn_sqrtf(fmaxf(ep * (1.f + a), 0.f));
                    av[t] = a; bv[t] = bm * ii * vs[(tq * 16 + t) * 128 + ch];
                    F.AB[((size_t)d * MALL + (size_t)(seq0 + t0 + tq * 16 + t)) * 512 + cidx] = pk2(ep, bv[t]); } }
            }
            { float A = 1.f, B = 0.f;
                if (d == 0) {
#pragma unroll
                    for (int t = 0; t < 16; ++t) { B = av[t] * B + bv[t]; A *= av[t]; }
                } else {
#pragma unroll
                    for (int t = 15; t >= 0; --t) { B = av[t] * B + bv[t]; A *= av[t]; }
                }
                sub[(tq * 128 + ch) * 2] = A; sub[(tq * 128 + ch) * 2 + 1] = B; }
            __syncthreads();
            if (!final) {
                if (F.tid < 128) { float A = 1.f, B = 0.f;
#pragma unroll
                    for (int s4 = 0; s4 < 4; ++s4) { const int q = d ? 3 - s4 : s4; const float As = sub[(q * 128 + ch) * 2], Bs = sub[(q * 128 + ch) * 2 + 1]; B = As * B + Bs; A *= As; }
                    float* dst = F.sum + ((size_t)(sc * 2 + d) * 512 + cidx) * 2; dst[0] = A; dst[1] = B; }
                __syncthreads();
            } else {
                if (d == 1) {
#pragma unroll
                    for (int k = 0; k < 2; ++k) { const int it = F.tid + 512 * k; const int r = it >> 4, c8 = (it & 15) * 8; *(LAS v4u*)(gb + r * 128 + c8) = gq[k]; } }
                if (F.tid < 128) { float h = car[(i * 2 + d) * 128 + ch];
                    if (d == 0) {
#pragma unroll
                        for (int q = 0; q < 4; ++q) { cin[q * 128 + ch] = h; h = sub[(q * 128 + ch) * 2] * h + sub[(q * 128 + ch) * 2 + 1]; }
                    } else {
#pragma unroll
                        for (int q = 3; q >= 0; --q) { cin[q * 128 + ch] = h; h = sub[(q * 128 + ch) * 2] * h + sub[(q * 128 + ch) * 2 + 1]; }
                    } }
                __syncthreads();
                float h = cin[tq * 128 + ch];
                if (d == 0) {
#pragma unroll
                    for (int t = 0; t < 16; ++t) { h = av[t] * h + bv[t]; y[t] = h; }
                } else {
#pragma unroll
                    for (int t = 15; t >= 0; --t) { h = av[t] * h + bv[t]; y[t] += h; }
                }
            }
        }
        if (final) {
#pragma unroll
            for (int t = 0; t < 16; ++t) { LAS bf16* gp = gb + (tq * 16 + t) * 128 + ch; *gp = (bf16)f2bf(y[t] * gelu_tanh(bf2f(*gp))); }
            __syncthreads();
#pragma unroll
            for (int k = 0; k < 2; ++k) { const int it = F.tid + 512 * k; const int r = it >> 4, c8 = (it & 15) * 8; *(v4u*)(F.XN + (size_t)(seq0 + t0 + r) * D + 512 + 128 * n + c8) = *(const LAS v4u*)(gb + r * 128 + c8); }
            __syncthreads();
        }
    }
}
__device__ __forceinline__ void lru_final_group(Frame& F, int b, int n, bool is_lat, int c0, int nch) {
    const int seq0 = is_lat ? b * SEQ : MLAT + b * CTXL;
    const int ch = F.tid & 127, tq = F.tid >> 7, cidx = 128 * n + ch;
    LAS float* sub = (LAS float*)(F.lds + LRU_SUB);
    LAS float* cin = (LAS float*)(F.lds + LRU_CIN);
    LAS bf16* gb = (LAS bf16*)(F.lds + LRU_PRE);
    const LAS float* car = (const LAS float*)(F.lds + LRU_CAR);
    lru_carries(F, b, n, is_lat, c0, nch);
    for (int i = 0; i < nch; ++i) {
        const int t0 = (c0 + i) * 64;
        unsigned ab[2][16]; v4u gq[2];
#pragma unroll
        for (int d = 0; d < 2; ++d)
#pragma unroll
            for (int t = 0; t < 16; ++t) ab[d][t] = F.AB[((size_t)d * MALL + (size_t)(seq0 + t0 + tq * 16 + t)) * 512 + cidx];
#pragma unroll
        for (int k = 0; k < 2; ++k) { const int it = F.tid + 512 * k; const int r = it >> 4, c8 = (it & 15) * 8; gq[k] = *(const v4u*)(F.P + (size_t)(seq0 + t0 + r) * 2048 + 1536 + 128 * n + c8); }
        { float A = 1.f, B = 0.f;
#pragma unroll
            for (int t = 0; t < 16; ++t) { const float a = 1.f - __uint_as_float(ab[0][t] << 16), bq = __uint_as_float(ab[0][t] & 0xffff0000u); B = a * B + bq; A *= a; }
            sub[((0 * 4 + tq) * 128 + ch) * 2] = A; sub[((0 * 4 + tq) * 128 + ch) * 2 + 1] = B;
            A = 1.f; B = 0.f;
#pragma unroll
            for (int t = 15; t >= 0; --t) { const float a = 1.f - __uint_as_float(ab[1][t] << 16), bq = __uint_as_float(ab[1][t] & 0xffff0000u); B = a * B + bq; A *= a; }
            sub[((1 * 4 + tq) * 128 + ch) * 2] = A; sub[((1 * 4 + tq) * 128 + ch) * 2 + 1] = B; }
#pragma unroll
        for (int k = 0; k < 2; ++k) { const int it = F.tid + 512 * k; const int r = it >> 4, c8 = (it & 15) * 8; *(LAS v4u*)(gb + r * 128 + c8) = gq[k]; }
        __syncthreads();
        if (F.tid < 256) {
            const int dir = F.tid >> 7; float h = car[(i * 2 + dir) * 128 + ch];
            if (dir == 0) {
#pragma unroll
                for (int q = 0; q < 4; ++q) { cin[(0 * 4 + q) * 128 + ch] = h; h = sub[((0 * 4 + q) * 128 + ch) * 2] * h + sub[((0 * 4 + q) * 128 + ch) * 2 + 1]; }
            } else {
#pragma unroll
                for (int q = 3; q >= 0; --q) { cin[(1 * 4 + q) * 128 + ch] = h; h = sub[((1 * 4 + q) * 128 + ch) * 2] * h + sub[((1 * 4 + q) * 128 + ch) * 2 + 1]; }
            }
        }
        __syncthreads();
        {
            float y[16]; float h = cin[(0 * 4 + tq) * 128 + ch];
#pragma unroll
            for (int t = 0; t < 16; ++t) { const float a = 1.f - __uint_as_float(ab[0][t] << 16), bq = __uint_as_float(ab[0][t] & 0xffff0000u); h = a * h + bq; y[t] = h; }
            h = cin[(1 * 4 + tq) * 128 + ch];
#pragma unroll
            for (int t = 15; t >= 0; --t) { const float a = 1.f - __uint_as_float(ab[1][t] << 16), bq = __uint_as_float(ab[1][t] & 0xffff0000u); h = a * h + bq; y[t] += h; }
#pragma unroll
            for (int t = 0; t < 16; ++t) { LAS bf16* gp = gb + (tq * 16 + t) * 128 + ch; *gp = (bf16)f2bf(y[t] * gelu_tanh(bf2f(*gp))); }
        }
        __syncthreads();
#pragma unroll
        for (int k = 0; k < 2; ++k) { const int it = F.tid + 512 * k; const int r = it >> 4, c8 = (it & 15) * 8; *(v4u*)(F.XN + (size_t)(seq0 + t0 + r) * D + 512 + 128 * n + c8) = *(const LAS v4u*)(gb + r * 128 + c8); }
        __syncthreads();
    }
}
__device__ __forceinline__ void lru_phase(Frame& F, bool final) {
    if (!final) {
        for (int gi = F.vcu; gi < 256; gi += F.G) lru_group(F, gi >> 7, (gi >> 5) & 3, true, (gi & 31) * 4, 4, false);
        for (int k = F.vcu; k < 32; k += F.G) lru_group(F, k >> 4, (k >> 2) & 3, false, k & 3, 1, false);
    } else {
        for (int gi = F.vcu; gi < 256; gi += F.G) lru_final_group(F, gi >> 7, (gi >> 5) & 3, true, (gi & 31) * 4, 4);
        for (int k = F.vcu; k < 32; k += F.G) lru_final_group(F, k >> 4, (k >> 2) & 3, false, k & 3, 1);
    }
}

__device__ __forceinline__ LAS int* build_tiles(Frame& F, int layer) {
    LAS int* ts = (LAS int*)(F.lds + TS_OFF);
    if (F.tid == 0) { int a = 0;
        for (int e = 0; e < 16; ++e) { const int c = (int)__hip_atomic_load(F.ctl + CW_CNT + layer * 64 + e, RLX_AGENT); ts[e] = a; ts[17 + e] = c; a += (c + 255) >> 8; }
        ts[16] = a; }
    __syncthreads();
    return ts;
}

constexpr int RT_TPW = 9;
__device__ __forceinline__ void route_phase(Frame& F, int layer, int nrows) {
    LAS bf16* RwT = (LAS bf16*)F.lds;
    LAS int* lcnt = (LAS int*)(F.lds + 36864);
    LAS int* lbase = lcnt + 16;
    LAS int* tabi = lbase + 16;
    LAS float* tabw = (LAS float*)(tabi + 512);
    for (int i = F.tid; i < 16384; i += NWAVES * 64) RwT[(i & 15) * 1032 + (i >> 4)] = (bf16)f2bf(F.router_w[i]);
    if (F.tid < 16) lcnt[F.tid] = 0;
    __syncthreads();
    const int per = (nrows + F.G - 1) / F.G, tok0 = blockIdx.x * per;
    const int wt0 = F.wave * RT_TPW; int wn = per - wt0; wn = wn > RT_TPW ? RT_TPW : wn; if (tok0 + wt0 + wn > nrows) wn = nrows - tok0 - wt0;
    if (wn > 0) {
        for (int tb = 0; tb < wn; tb += 3) {
            f32x4 v[3][4];
#pragma unroll
            for (int u = 0; u < 3; ++u) { const int tk = tok0 + wt0 + (tb + u < wn ? tb + u : wn - 1);
#pragma unroll
                for (int j = 0; j < 4; ++j) { const v2u w = *(const v2u*)(F.H + (size_t)tk * D + 4 * F.lane + 256 * j);
                    v[u][j] = (f32x4){__uint_as_float(w.x << 16), __uint_as_float(w.x & 0xffff0000u), __uint_as_float(w.y << 16), __uint_as_float(w.y & 0xffff0000u)}; } }
#pragma unroll
            for (int u = 0; u < 3; ++u) if (tb + u < wn) { const int tk = tok0 + wt0 + tb + u; const int mi = (tk >> 13) > 2 ? 2 : (tk >> 13);
                const float* md = F.mod + (layer * 3 + mi) * 6144; f32x4 t[4];
                norm_mod_store(v[u], F.gffn + layer * D, md + 4096, md + 3072, F.XN + (size_t)tk * D, F.lane, t); }
        }
        asm volatile("s_waitcnt vmcnt(0)" ::: "memory");
        const int tl = (F.lane & 15) < wn ? (F.lane & 15) : wn - 1, kq = F.lane >> 4;
        const bf16* xb = F.XN + (size_t)(tok0 + wt0 + tl) * D + 8 * kq;
        const LAS bf16* ab = RwT + (F.lane & 15) * 1032 + 8 * kq;
        f32x4 acc = {0.f, 0.f, 0.f, 0.f};
#pragma unroll 8
        for (int ks = 0; ks < 32; ++ks) { const bf16x8 bq = *(const bf16x8*)(xb + 32 * ks); const bf16x8 aq = *(const LAS bf16x8*)(ab + 32 * ks); acc = __builtin_amdgcn_mfma_f32_16x16x32_bf16(aq, bq, acc, 0, 0, 0); }
        const int g = F.lane >> 4;
        float sc[4], sl[4];
#pragma unroll
        for (int j = 0; j < 4; ++j) { sc[j] = 1.f / (1.f + __expf(-acc[j])); sl[j] = sc[j] + F.router_bias[4 * g + j]; }
        const float gs = fmaxf(fmaxf(fmaxf(sl[0] + sl[1], sl[0] + sl[2]), fmaxf(sl[0] + sl[3], sl[1] + sl[2])), fmaxf(sl[1] + sl[3], sl[2] + sl[3]));
        float bgs = gs; int bg = g;
#pragma unroll
        for (int off = 16; off < 64; off <<= 1) { const float os = __shfl_xor(bgs, off); const int og = __shfl_xor(bg, off); if (os > bgs || (os == bgs && og < bg)) { bgs = os; bg = og; } }
        if (bg == g && (F.lane & 15) < wn) {
            int i1 = 0; float v1 = sl[0], s1 = sc[0];
#pragma unroll
            for (int j = 1; j < 4; ++j) if (sl[j] > v1) { v1 = sl[j]; i1 = j; s1 = sc[j]; }
            int i2 = -1; float v2 = -INFINITY, s2 = 0.f;
#pragma unroll
            for (int j = 0; j < 4; ++j) if (j != i1 && sl[j] > v2) { v2 = sl[j]; i2 = j; s2 = sc[j]; }
            const int e0 = 4 * g + i1, e1 = 4 * g + i2; const float inv = 1.f / (s1 + s2); const int ti = wt0 + (F.lane & 15);
            const int p0 = __hip_atomic_fetch_add(lcnt + e0, 1, __ATOMIC_RELAXED, __HIP_MEMORY_SCOPE_WORKGROUP), p1 = __hip_atomic_fetch_add(lcnt + e1, 1, __ATOMIC_RELAXED, __HIP_MEMORY_SCOPE_WORKGROUP);
            tabi[ti * 4 + 0] = e0; tabi[ti * 4 + 1] = p0; tabi[ti * 4 + 2] = e1; tabi[ti * 4 + 3] = p1; tabw[ti * 2] = s1 * inv; tabw[ti * 2 + 1] = s2 * inv;
        }
    }
    __syncthreads();
    if (F.tid < 16) lbase[F.tid] = (int)__hip_atomic_fetch_add(F.ctl + CW_CNT + layer * 64 + F.tid, (unsigned)lcnt[F.tid], RLX_AGENT);
    __syncthreads();
    if (F.tid < per && tok0 + F.tid < nrows) { const int token = tok0 + F.tid;
#pragma unroll
        for (int k = 0; k < 2; ++k) { const int e = tabi[F.tid * 4 + 2 * k], idx = lbase[e] + tabi[F.tid * 4 + 2 * k + 1];
            F.list[(size_t)layer * 16 * CAP + e * CAP + idx] = token; F.rslot[((size_t)layer * MALL + token) * 2 + k] = e * CAP + idx; F.rw[((size_t)layer * MALL + token) * 2 + k] = tabw[F.tid * 2 + k]; } }
    __syncthreads();
}

__device__ __forceinline__ void combine_phase(Frame& F, int layer, int nrows, bool final) {
    LAS int* ts = build_tiles(F, layer);
    const int gw = F.vcu * NWAVES + F.wave, NGW = F.G * NWAVES;
    for (int row = gw; row < nrows; row += NGW) {
        const int mi = (row >> 13) > 2 ? 2 : (row >> 13);
        const int s0 = F.rslot[((size_t)layer * MALL + row) * 2], s1 = F.rslot[((size_t)layer * MALL + row) * 2 + 1];
        const float w0 = F.rw[((size_t)layer * MALL + row) * 2], w1 = F.rw[((size_t)layer * MALL + row) * 2 + 1];
        const int e0 = s0 / CAP, e1 = s1 / CAP;
        const size_t y0 = (size_t)(ts[e0] * 256 + (s0 - e0 * CAP)), y1 = (size_t)(ts[e1] * 256 + (s1 - e1 * CAP));
        const float* md = F.mod + (layer * 3 + mi) * 6144;
        f32x4 v[4], t[4];
#pragma unroll
        for (int j = 0; j < 4; ++j) { const int col = 4 * F.lane + 256 * j;
            const v2u a = *(const v2u*)(F.Y + y0 * D + col), bq = *(const v2u*)(F.Y + y1 * D + col);
            f32x4 fa, fb; fa.x = __uint_as_float(a.x << 16); fa.y = __uint_as_float(a.x & 0xffff0000u); fa.z = __uint_as_float(a.y << 16); fa.w = __uint_as_float(a.y & 0xffff0000u);
            fb.x = __uint_as_float(bq.x << 16); fb.y = __uint_as_float(bq.x & 0xffff0000u); fb.z = __uint_as_float(bq.y << 16); fb.w = __uint_as_float(bq.y & 0xffff0000u);
            const f32x4 g2 = *(const f32x4*)(md + 5120 + col);
            const v2u hw = *(const v2u*)(F.H + (size_t)row * D + col);
            const f32x4 hv = {__uint_as_float(hw.x << 16), __uint_as_float(hw.x & 0xffff0000u), __uint_as_float(hw.y << 16), __uint_as_float(hw.y & 0xffff0000u)};
            v[j] = hv + g2 * (fa * w0 + fb * w1); }
        if (!final) {
#pragma unroll
            for (int j = 0; j < 4; ++j) { v2u hw; hw.x = pk2(v[j].x, v[j].y); hw.y = pk2(v[j].z, v[j].w); *(v2u*)(F.H + (size_t)row * D + 4 * F.lane + 256 * j) = hw; }
            const float* md1 = F.mod + ((layer + 1) * 3 + mi) * 6144;
            norm_mod_store(v, F.gmix + (layer + 1) * D, md1 + 1024, md1, F.XN + (size_t)row * D, F.lane, t);
        } else {
            float s = 0.f;
#pragma unroll
            for (int j = 0; j < 4; ++j) s += (v[j].x * v[j].x + v[j].y * v[j].y) + (v[j].z * v[j].z + v[j].w * v[j].w);
            const float rstd = 1.f / sqrtf(wave_sum(s) * (1.f / D) + EPS);
#pragma unroll
            for (int j = 0; j < 4; ++j) { const int col = 4 * F.lane + 256 * j; *(f32x4*)(F.out + (size_t)row * D + col) = v[j] * rstd * *(const f32x4*)(F.final_g + col); }
        }
    }
}

typedef __bf16 bf16x2_t __attribute__((ext_vector_type(2)));
__device__ __forceinline__ unsigned cvtpk(float lo, float hi) { f32x2 v = {lo, hi}; return __builtin_bit_cast(unsigned, __builtin_convertvector(v, bf16x2_t)); }
#define NAT_THR 8.0f
__device__ __forceinline__ void natten_task(Frame& F, int b, int h, int r, const LAS float* rpbL) {
    const int lane = F.lane, q = lane & 15, fq = lane >> 4;
    const int rs = (r - 4) < 0 ? 0 : ((r - 4) > NROWS - 8 ? NROWS - 8 : (r - 4));
    const size_t qrow0 = (size_t)b * SEQ + (size_t)r * GRIDW;
    bf16x8 Qf[4][2];
#pragma unroll
    for (int qb = 0; qb < 4; ++qb)
#pragma unroll
        for (int dh = 0; dh < 2; ++dh) Qf[qb][dh] = *(const bf16x8*)(F.P + (qrow0 + 16 * qb + q) * P1LD + 1536 + 64 * h + 32 * dh + 8 * fq);
    f32x4 OT[4][4]; float mrun[4], lrun[4]; int cbase[4], bbase[4];
#pragma unroll
    for (int qb = 0; qb < 4; ++qb) { const int c = 16 * qb + q; const int cs = (c - 8) < 0 ? 0 : ((c - 8) > GRIDW - 16 ? GRIDW - 16 : (c - 8));
        cbase[qb] = 4 * fq - cs; bbase[qb] = 4 * fq - c + 15; mrun[qb] = -INFINITY; lrun[qb] = 0.f;
#pragma unroll
        for (int db = 0; db < 4; ++db) OT[qb][db] = (f32x4){0.f, 0.f, 0.f, 0.f}; }
    const bf16* kbase = F.P + 2048 + 64 * h + 8 * fq;
    const bf16* vbase = F.VT + (size_t)(64 * h + q) * MALL + 4 * fq;
    for (int kk = 0; kk < 8; ++kk) {
        const int kr = rs + kk; const size_t krow0 = (size_t)b * SEQ + (size_t)kr * GRIDW;
        const LAS float* brow = rpbL + (h * 15 + (kr - r + 7)) * 31;
        bf16x8 Kf[4][2];
#pragma unroll
        for (int kb = 0; kb < 4; ++kb)
#pragma unroll
            for (int dh = 0; dh < 2; ++dh) Kf[kb][dh] = *(const bf16x8*)(kbase + (krow0 + 16 * kb + q) * P1LD + 32 * dh);
        f32x4 S[4][4];
#pragma unroll
        for (int qb = 0; qb < 4; ++qb) {
            constexpr int KB0[4] = {0, 0, 1, 2}, KB1[4] = {2, 3, 4, 4};
            float ml = -INFINITY;
#pragma unroll
            for (int kb = 0; kb < 4; ++kb) if (kb >= KB0[qb] && kb < KB1[qb]) {
                f32x4 a = __builtin_amdgcn_mfma_f32_16x16x32_bf16(Kf[kb][0], Qf[qb][0], (f32x4){0.f, 0.f, 0.f, 0.f}, 0, 0, 0);
                a = __builtin_amdgcn_mfma_f32_16x16x32_bf16(Kf[kb][1], Qf[qb][1], a, 0, 0, 0);
#pragma unroll
                for (int j = 0; j < 4; ++j) { const bool valid = (unsigned)(cbase[qb] + 16 * kb + j) < 16u; const float bias = brow[bbase[qb] + 16 * kb + j];
                    a[j] = valid ? a[j] + bias : -INFINITY; ml = fmaxf(ml, a[j]); }
                S[qb][kb] = a;
            }
            ml = fmaxf(ml, __shfl_xor(ml, 16)); ml = fmaxf(ml, __shfl_xor(ml, 32));
            if (__any(ml > mrun[qb] + NAT_THR)) { const float mn = fmaxf(mrun[qb], ml), al = __builtin_amdgcn_exp2f(mrun[qb] - mn); mrun[qb] = mn; lrun[qb] *= al;
#pragma unroll
                for (int db = 0; db < 4; ++db) OT[qb][db] = OT[qb][db] * al; }
            float ls = 0.f;
#pragma unroll
            for (int kb = 0; kb < 4; ++kb) if (kb >= KB0[qb] && kb < KB1[qb]) {
#pragma unroll
                for (int j = 0; j < 4; ++j) { const float p = __builtin_amdgcn_exp2f(S[qb][kb][j] - mrun[qb]); S[qb][kb][j] = p; ls += p; } }
            else S[qb][kb] = (f32x4){0.f, 0.f, 0.f, 0.f};
            lrun[qb] += ls;
        }
#pragma unroll
        for (int g = 0; g < 2; ++g) {
            bf16x8 Vf[4];
#pragma unroll
            for (int db = 0; db < 4; ++db) { const bf16* vp = vbase + (size_t)(16 * db) * MALL + krow0 + 32 * g; const v2u lo = *(const v2u*)vp, hi = *(const v2u*)(vp + 16);
                Vf[db] = __builtin_bit_cast(bf16x8, (v4u){lo.x, lo.y, hi.x, hi.y}); }
#pragma unroll
            for (int qb = 0; qb < 4; ++qb) {
                constexpr int GOK[4][2] = {{1, 0}, {1, 1}, {1, 1}, {0, 1}};
                if (GOK[qb][g]) {
                    const f32x4 s0 = S[qb][2 * g], s1 = S[qb][2 * g + 1];
                    const bf16x8 pt = __builtin_bit_cast(bf16x8, (v4u){cvtpk(s0[0], s0[1]), cvtpk(s0[2], s0[3]), cvtpk(s1[0], s1[1]), cvtpk(s1[2], s1[3])});
#pragma unroll
                    for (int db = 0; db < 4; ++db) OT[qb][db] = __builtin_amdgcn_mfma_f32_16x16x32_bf16(Vf[db], pt, OT[qb][db], 0, 0, 0);
                }
            }
        }
    }
    for (int g = 0; g < 8; ++g) {
        const size_t ct0 = (size_t)MLAT + (size_t)b * CTXL + 32 * g;
        bf16x8 Kf[2][2];
#pragma unroll
        for (int kb = 0; kb < 2; ++kb)
#pragma unroll
            for (int dh = 0; dh < 2; ++dh) Kf[kb][dh] = *(const bf16x8*)(kbase + (ct0 + 16 * kb + q) * P1LD + 32 * dh);
        bf16x8 Vf[4];
#pragma unroll
        for (int db = 0; db < 4; ++db) { const bf16* vp = vbase + (size_t)(16 * db) * MALL + ct0; const v2u lo = *(const v2u*)vp, hi = *(const v2u*)(vp + 16);
            Vf[db] = __builtin_bit_cast(bf16x8, (v4u){lo.x, lo.y, hi.x, hi.y}); }
#pragma unroll
        for (int qb = 0; qb < 4; ++qb) {
            f32x4 s0 = __builtin_amdgcn_mfma_f32_16x16x32_bf16(Kf[0][0], Qf[qb][0], (f32x4){0.f, 0.f, 0.f, 0.f}, 0, 0, 0);
            s0 = __builtin_amdgcn_mfma_f32_16x16x32_bf16(Kf[0][1], Qf[qb][1], s0, 0, 0, 0);
            f32x4 s1 = __builtin_amdgcn_mfma_f32_16x16x32_bf16(Kf[1][0], Qf[qb][0], (f32x4){0.f, 0.f, 0.f, 0.f}, 0, 0, 0);
            s1 = __builtin_amdgcn_mfma_f32_16x16x32_bf16(Kf[1][1], Qf[qb][1], s1, 0, 0, 0);
            float ml = fmaxf(fmaxf(fmaxf(s0[0], s0[1]), fmaxf(s0[2], s0[3])), fmaxf(fmaxf(s1[0], s1[1]), fmaxf(s1[2], s1[3])));
            ml = fmaxf(ml, __shfl_xor(ml, 16)); ml = fmaxf(ml, __shfl_xor(ml, 32));
            if (__any(ml > mrun[qb] + NAT_THR)) { const float mn = fmaxf(mrun[qb], ml), al = __builtin_amdgcn_exp2f(mrun[qb] - mn); mrun[qb] = mn; lrun[qb] *= al;
#pragma unroll
                for (int db = 0; db < 4; ++db) OT[qb][db] = OT[qb][db] * al; }
            float ls = 0.f;
#pragma unroll
            for (int j = 0; j < 4; ++j) { s0[j] = __builtin_amdgcn_exp2f(s0[j] - mrun[qb]); s1[j] = __builtin_amdgcn_exp2f(s1[j] - mrun[qb]); ls += s0[j] + s1[j]; }
            lrun[qb] += ls;
            const bf16x8 pt = __builtin_bit_cast(bf16x8, (v4u){cvtpk(s0[0], s0[1]), cvtpk(s0[2], s0[3]), cvtpk(s1[0], s1[1]), cvtpk(s1[2], s1[3])});
#pragma unroll
            for (int db = 0; db < 4; ++db) OT[qb][db] = __builtin_amdgcn_mfma_f32_16x16x32_bf16(Vf[db], pt, OT[qb][db], 0, 0, 0);
        }
    }
#pragma unroll
    for (int qb = 0; qb < 4; ++qb) { float l = lrun[qb]; l += __shfl_xor(l, 16); l += __shfl_xor(l, 32); const float il = 1.f / l;
        bf16* op = F.XN + (qrow0 + 16 * qb + q) * D + 512 + 64 * h + 4 * fq;
#pragma unroll
        for (int db = 0; db < 4; ++db) { const f32x4 o = OT[qb][db] * il; v2u w; w.x = cvtpk(o[0], o[1]); w.y = cvtpk(o[2], o[3]); *(v2u*)(op + 16 * db) = w; } }
}
__device__ __forceinline__ void natten_phase(Frame& F) {
    LAS float* rpbL = (LAS float*)(F.lds + 1024);
    for (int i = F.tid; i < 8 * 15 * 31; i += NWAVES * 64) rpbL[i] = F.d_rpb[i] * 1.4426950408889634f;
    __syncthreads();
    for (int t = F.vcu; t < 256; t += F.G) natten_task(F, t >> 7, (t >> 4) & 7, (t & 15) * 8 + F.wave, rpbL);
    const int gw = F.vcu * NWAVES + F.wave, NGW = F.G * NWAVES;
    for (int qi = gw; qi < MLAT; qi += NGW) {
        const int b = qi >> 13, tt = qi & 8191;
        const int ch0 = 8 * F.lane; float accv[8];
#pragma unroll
        for (int d = 0; d < 8; ++d) accv[d] = 0.f;
#pragma unroll
        for (int k = 0; k < 3; ++k) { const int t2 = tt + k - 1;
            const int t2c = t2 < 0 ? 0 : (t2 >= SEQ ? SEQ - 1 : t2); const float ok = (t2 == t2c) ? 1.f : 0.f;
            float xi[8], cg[8]; const bf16* p = F.P + ((size_t)b * SEQ + t2c) * P1LD + ch0; unpack8(*(const v4u*)p, xi); unpack8(*(const v4u*)(p + 1024), cg);
#pragma unroll
            for (int d = 0; d < 8; ++d) accv[d] += (ok * F.c_conv_w[k * 512 + ch0 + d]) * (cg[d] * xi[d]); }
        float bgv[8]; unpack8(*(const v4u*)(F.P + (size_t)qi * P1LD + 512 + ch0), bgv);
        v4u w2; w2.x = pk2(bgv[0] * accv[0], bgv[1] * accv[1]); w2.y = pk2(bgv[2] * accv[2], bgv[3] * accv[3]); w2.z = pk2(bgv[4] * accv[4], bgv[5] * accv[5]); w2.w = pk2(bgv[6] * accv[6], bgv[7] * accv[7]);
        *(v4u*)(F.XN + (size_t)qi * D + ch0) = w2;
    }
}

template <int TM, class EPI>
__device__ __forceinline__ void mini_gemm(const bf16* A, const bf16* Bt, int lane, int wave, const EPI& epi) {
    constexpr int NSUB = (TM == 64) ? 2 : 1;
    const int r = lane & 15, kq = lane >> 4;
    const int rb = (TM == 64) ? (wave & 3) : (wave & 1);
    const int cb0 = (TM == 64) ? (wave >> 2) * 2 : (wave >> 1);
    const bf16* ap = A + (size_t)(16 * rb + r) * 1024 + 8 * kq;
    const bf16* bp = Bt + (size_t)(16 * cb0 + r) * 1024 + 8 * kq;
    f32x4 acc[NSUB];
#pragma unroll
    for (int j = 0; j < NSUB; ++j) acc[j] = (f32x4){0.f, 0.f, 0.f, 0.f};
#pragma unroll 8
    for (int ks = 0; ks < 32; ++ks) { const bf16x8 af = *(const bf16x8*)(ap + 32 * ks);
#pragma unroll
        for (int j = 0; j < NSUB; ++j) { const bf16x8 bq = *(const bf16x8*)(bp + (size_t)j * 16 * 1024 + 32 * ks); acc[j] = __builtin_amdgcn_mfma_f32_16x16x32_bf16(bq, af, acc[j], 0, 0, 0); } }
#pragma unroll
    for (int j = 0; j < NSUB; ++j) epi(16 * rb + r, 16 * (cb0 + j) + 4 * kq, acc[j]);
}
struct Args { const float* in[28]; float* out; unsigned char* ws; int ph_lo, ph_hi, sub, pad; };
__global__ void __launch_bounds__(NWAVES * 64, 2) hybrid_fwd(Args args) {
    extern __shared__ __attribute__((aligned(16))) unsigned char lds[];
    Frame F;
    F.lds = (LAS unsigned char*)lds;
    F.MISC = (volatile LAS unsigned*)(F.lds + MISC_OFF);
    F.tid = threadIdx.x; F.lane = F.tid & 63; F.wave = __builtin_amdgcn_readfirstlane(F.tid >> 6);
    F.sub = args.sub; F.G = gridDim.x; { const int bx = blockIdx.x; F.vcu = (F.G % 8 == 0) ? (bx % 8) * (F.G / 8) + bx / 8 : bx; }
    unsigned char* ws = args.ws;
    F.ctl = (gu32*)(ws + WS_CTL);
    F.x = args.in[0]; F.c = args.in[1]; F.ctx = args.in[2]; F.c_ctx = args.in[3]; F.ada_w = args.in[4]; F.ada_b = args.in[5]; F.gmix = args.in[6]; F.gffn = args.in[7];
    F.w_out = args.in[8]; F.ab_w_in = args.in[9]; F.a_dw_w = args.in[10]; F.a_dw_b = args.in[11]; F.a_ln_g = args.in[12]; F.a_ln_b = args.in[13]; F.b_conv_w = args.in[14]; F.b_conv_b = args.in[15];
    F.b_gate_w = args.in[16]; F.b_gate_b = args.in[17]; F.b_lambda = args.in[18]; F.cd_w_in = args.in[19]; F.c_conv_w = args.in[20]; F.d_rpb = args.in[21]; F.router_w = args.in[22]; F.router_bias = args.in[23];
    F.moe_wg = args.in[24]; F.moe_wu = args.in[25]; F.moe_wd = args.in[26]; F.final_g = args.in[27]; F.out = args.out;
    F.mod = (float*)(ws + WS_MOD); F.sum = (float*)(ws + WS_SUM); F.list = (int*)(ws + WS_LIST); F.rslot = (int*)(ws + WS_RSLOT); F.rw = (float*)(ws + WS_RW);
    F.Wab = (bf16*)(ws + WS_WAB); F.Wout = (bf16*)(ws + WS_WOUT); F.Wcd = (bf16*)(ws + WS_WCD); F.Wgu = (bf16*)(ws + WS_WGU); F.Wd = (bf16*)(ws + WS_WD); F.WgT = (bf16*)(ws + WS_GATEW);
    F.XN = (bf16*)(ws + WS_XN); F.P = (bf16*)(ws + WS_P); F.Y = (bf16*)(ws + WS_Y); F.HID = (bf16*)(ws + WS_HID); F.VT = (bf16*)(ws + WS_VT); F.H = (bf16*)(ws + WS_H); F.AB = (unsigned*)(ws + WS_H);
    for (int u = F.tid; u < (LDS_BYTES - LDSCTL_OFF) / 4; u += NWAVES * 64) ((LAS unsigned*)(F.lds + LDSCTL_OFF))[u] = 0u;
    __syncthreads();
    XcdBarrier bar; bar.bar = (unsigned*)(F.ctl + CW_BAR); bar.x = 0; bar.st = nullptr;
    const int lo = args.ph_lo, hi = args.ph_hi;
    const bool multi = (hi - lo) > 1;
    if (multi) bar = xcd_barrier_post((unsigned*)(F.ctl + CW_BAR), F.MISC + 8);
#define IN(k) (lo <= (k) && (k) < hi)
#define SEAM(k) do { if (IN(k) && IN((k) + 1)) xcd_barrier(bar); } while (0)
    const int bx = (int)blockIdx.x;

    if (IN(0)) { for (int rep = 0; rep < NREP(0); ++rep) p0_prologue(F); } SEAM(0);
    if (IN(1)) { for (int rep = 0; rep < NREP(1); ++rep) p1_norm0(F); } SEAM(1);
    if (IN(2)) for (int rep = 0; rep < NREP(2); ++rep) {
        pg8::SchedPlain S; S.so.init(MLAT / 256, 2048 / 256, F.G, bx); S.A = (const char*)F.XN; S.B = (const char*)F.Wab; S.tstep = (size_t)256 * 1024 * 2;
        pg8::EpiBf16 E{F.P, 2048};
        pg8::gemm_phase<pg8::EpiBf16, pg8::SchedPlain, true, true>(F.lds, 1024, S, E);
        for (int t = F.vcu; t < 256; t += F.G) {
            const int tm = t >> 5, tn = t & 31; bf16* Pp = F.P;
            mini_gemm<64>(F.XN + (size_t)(MLAT + 64 * tm) * D, F.Wab + (size_t)(64 * tn) * 1024, F.lane, F.wave,
                [=](int row, int col, f32x4 a) { v2u w; w.x = pk2(a[0], a[1]); w.y = pk2(a[2], a[3]); *(v2u*)(Pp + (size_t)(MLAT + 64 * tm + row) * 2048 + 64 * tn + col) = w; });
        }
    } SEAM(2);
    if (IN(3)) for (int rep = 0; rep < NREP(3); ++rep) {
        if (args.sub != 2) { for (int u = F.vcu; u < MLAT / 32; u += F.G) conf_unit<32>(F, u * 32);
            for (int u = F.vcu; u < MCTX / 2; u += F.G) conf_unit<2>(F, MLAT + u * 2); }
        if (args.sub != 1) lru_phase(F, false);
    } SEAM(3);
    if (IN(4)) { for (int rep = 0; rep < NREP(4); ++rep) lru_phase(F, true); } SEAM(4);
    if (IN(5)) {
        pg8::SchedPlain S; S.so.init(MLAT / 256, 4, F.G, bx); S.A = (const char*)F.XN; S.B = (const char*)F.Wout; S.tstep = (size_t)256 * 1024 * 2;
        pg8::EpiRes E{F.x, F.ctx, nullptr, F.H, F.mod + 0 * 3 * 6144 + 2048};
        pg8::gemm_phase<pg8::EpiRes, pg8::SchedPlain, true, true>(F.lds, 1024, S, E);
        for (int t = F.vcu; t < 256; t += F.G) {
            const int tm = t >> 4, tn = t & 15; bf16* Hp = F.H; const float* cp = F.ctx; const float* g1 = F.mod + (0 * 3 + 2) * 6144 + 2048;
            mini_gemm<32>(F.XN + (size_t)(MLAT + 32 * tm) * D, F.Wout + (size_t)(64 * tn) * 1024, F.lane, F.wave,
                [=](int row, int col, f32x4 a) { const size_t rr = (size_t)(32 * tm + row) * D + 64 * tn + col;
                    const f32x4 v = *(const f32x4*)(cp + rr) + *(const f32x4*)(g1 + 64 * tn + col) * a; v2u w; w.x = pk2(v[0], v[1]); w.y = pk2(v[2], v[3]);
                    *(v2u*)(Hp + (size_t)MLAT * D + rr) = w; });
        }
    } SEAM(5);
    if (IN(6)) { route_phase(F, 0, MALL); } SEAM(6);
    if (IN(7)) for (int rep = 0; rep < NREP(7); ++rep) {
        LAS int* ts = build_tiles(F, 0);
        pg8::SchedMoeGU S; S.so.init(__builtin_amdgcn_readfirstlane(ts[16]), 4, F.G, bx); S.ts = ts; S.A = (const char*)F.XN; S.B = (const char*)F.Wgu; S.list = F.list;
        pg8::EpiGateUp E{F.HID};
        pg8::gemm_phase<pg8::EpiGateUp, pg8::SchedMoeGU, true, true>(F.lds, 1024, S, E);
    } SEAM(7);
    if (IN(8)) for (int rep = 0; rep < NREP(8); ++rep) {
        LAS int* ts = build_tiles(F, 0);
        pg8::SchedMoeDown S; S.so.init(__builtin_amdgcn_readfirstlane(ts[16]), 4, F.G, bx); S.ts = ts; S.A = (const char*)F.HID; S.B = (const char*)F.Wd;
        pg8::EpiBf16 E{F.Y, 1024};
        pg8::gemm_phase<pg8::EpiBf16, pg8::SchedMoeDown, true, true>(F.lds, 512, S, E);
    } SEAM(8);
    if (IN(9)) { combine_phase(F, 0, MALL, false); } SEAM(9);
    if (IN(10)) for (int rep = 0; rep < NREP(10); ++rep) {
        pg8::SchedInproj1 S; S.so.init(64, 10, F.G, bx); S.X = (const char*)F.XN; S.W = (const char*)F.Wcd; S.G = F.G; S.c = bx;
        pg8::EpiInproj1 E{F.P, F.VT};
        pg8::gemm_phase<pg8::EpiInproj1, pg8::SchedInproj1, true, true>(F.lds, 1024, S, E);
        for (int t = F.vcu; t < 256; t += F.G) {
            const int tt = t & 127, tm = tt >> 3, tn = tt & 7; bf16* Pp = F.P; bf16* Vp = F.VT;
            if (t < 128) mini_gemm<32>(F.XN + (size_t)(MLAT + 32 * tm) * D, F.Wcd + (size_t)(2048 + 64 * tn) * 1024, F.lane, F.wave,
                [=](int row, int col, f32x4 a) { v2u w; w.x = pk2(a[0], a[1]); w.y = pk2(a[2], a[3]); *(v2u*)(Pp + (size_t)(MLAT + 32 * tm + row) * P1LD + 2048 + 64 * tn + col) = w; });
            else mini_gemm<32>(F.Wcd + (size_t)(2560 + 32 * tm) * 1024, F.XN + (size_t)(MLAT + 64 * tn) * D, F.lane, F.wave,
                [=](int row, int col, f32x4 a) { v2u w; w.x = pk2(a[0], a[1]); w.y = pk2(a[2], a[3]); *(v2u*)(Vp + (size_t)(32 * tm + row) * MALL + MLAT + 64 * tn + col) = w; });
        }
    } SEAM(10);
    if (IN(11)) { for (int rep = 0; rep < NREP(11); ++rep) natten_phase(F); } SEAM(11);
    if (IN(12)) {
        pg8::SchedPlain S; S.so.init(MLAT / 256, 4, F.G, bx); S.A = (const char*)F.XN; S.B = (const char*)(F.Wout + (size_t)1024 * 1024); S.tstep = (size_t)256 * 1024 * 2;
        pg8::EpiRes E{nullptr, nullptr, F.H, F.H, F.mod + 1 * 3 * 6144 + 2048};
        pg8::gemm_phase<pg8::EpiRes, pg8::SchedPlain, true, true>(F.lds, 1024, S, E);
    } SEAM(12);
    if (IN(13)) { route_phase(F, 1, MLAT); } SEAM(13);
    if (IN(14)) for (int rep = 0; rep < NREP(14); ++rep) {
        LAS int* ts = build_tiles(F, 1);
        pg8::SchedMoeGU S; S.so.init(__builtin_amdgcn_readfirstlane(ts[16]), 4, F.G, bx); S.ts = ts; S.A = (const char*)F.XN; S.B = (const char*)(F.Wgu + (size_t)16 * 1024 * 1024); S.list = F.list + (size_t)16 * CAP;
        pg8::EpiGateUp E{F.HID};
        pg8::gemm_phase<pg8::EpiGateUp, pg8::SchedMoeGU, true, true>(F.lds, 1024, S, E);
    } SEAM(14);
    if (IN(15)) for (int rep = 0; rep < NREP(15); ++rep) {
        LAS int* ts = build_tiles(F, 1);
        pg8::SchedMoeDown S; S.so.init(__builtin_amdgcn_readfirstlane(ts[16]), 4, F.G, bx); S.ts = ts; S.A = (const char*)F.HID; S.B = (const char*)(F.Wd + (size_t)16 * 1024 * 512);
        pg8::EpiBf16 E{F.Y, 1024};
        pg8::gemm_phase<pg8::EpiBf16, pg8::SchedMoeDown, true, true>(F.lds, 512, S, E);
    } SEAM(15);
    if (IN(16)) { for (int rep = 0; rep < NREP(16); ++rep) combine_phase(F, 1, MLAT, true); }
#undef IN
#undef SEAM
}

extern "C" void kernel_launch(void* const* d_in, const int* in_sizes, int n_in, void* d_out, int out_size, void* d_ws, size_t ws_size, hipStream_t stream) {
    static int grid = 0;
    if (grid == 0) {
        if (n_in != 28 || in_sizes[0] != MLAT * D || out_size != MLAT * D || ws_size < WS_END) {
            fprintf(stderr, "kernel_launch: unexpected shapes / workspace (n_in %d, in0 %d, out %d, ws %zu < %zu); nothing launched\n", n_in, n_in > 0 ? in_sizes[0] : -1, out_size, ws_size, (size_t)WS_END); grid = -1; return; }
        int dev = 0, cus = 0, per_cu = 0;
        if (hipGetDevice(&dev) != hipSuccess || hipDeviceGetAttribute(&cus, hipDeviceAttributeMultiprocessorCount, dev) != hipSuccess) { grid = -1; return; }
        if (hipFuncSetAttribute((const void*)hybrid_fwd, hipFuncAttributeMaxDynamicSharedMemorySize, LDS_BYTES) != hipSuccess) { fprintf(stderr, "kernel_launch: hipFuncSetAttribute failed\n"); grid = -1; return; }
        if (hipOccupancyMaxActiveBlocksPerMultiprocessor(&per_cu, (const void*)hybrid_fwd, NWAVES * 64, LDS_BYTES) != hipSuccess || per_cu < 1) { fprintf(stderr, "kernel_launch: occupancy query reports %d\n", per_cu); per_cu = 1; }
        (void)hipGetLastError();
        grid = cus;
        if (grid != 256) fprintf(stderr, "kernel_launch: %d CUs\n", grid);
    }
    if (grid < 0) return;
    if (hipMemsetAsync((char*)d_ws + WS_CTL, 0, CTL_ZERO_BYTES, stream) != hipSuccess) return;
    Args a{};
    for (int i = 0; i < 28; ++i) a.in[i] = (const float*)d_in[i];
    a.out = (float*)d_out; a.ws = (unsigned char*)d_ws;
    if (MK_N_LAUNCHES == 1) { a.ph_lo = 0; a.ph_hi = NPH; hipLaunchKernelGGL(hybrid_fwd, dim3(grid), dim3(NWAVES * 64), LDS_BYTES, stream, a); }
    else for (int p = 0; p < NPH; ++p) { a.ph_lo = p; a.ph_hi = p + 1;
        const int reps = (p == PROBE_PHASE) ? 1 + PROBE_REPS : 1;
        for (int r = 0; r < reps; ++r) {
            a.sub = (r + 1 < reps) ? PROBE_SUB : 0;
            if (r > 0 && (p == 6 || p == 13)) (void)hipMemsetAsync((char*)d_ws + WS_CTL + (size_t)(CW_CNT + (p == 13 ? 64 : 0)) * 4, 0, 64, stream);
            hipLaunchKernelGGL(hybrid_fwd, dim3(grid), dim3(NWAVES * 64), LDS_BYTES, stream, a); } }
}
```
